# Optimizing an MI355X kernel written in HIP

```python
import jax, jax.numpy as jnp
from jax import lax
import numpy as np

D_MODEL = 1024
BATCH = 2
SEQ = 8192
DEPTH = 1

D_MIX = D_MODEL
D_MLSTM = D_MIX // 2
N_MLSTM_HEADS = 4
MLSTM_HEAD_DIM = D_MLSTM // N_MLSTM_HEADS
D_NA = D_MIX - D_MLSTM
N_NA_HEADS = 8
NA_HEAD_DIM = D_NA // N_NA_HEADS
GRID_W = 64
WIN_H_MAX = 8
WIN_W = 16
CHUNK = 128
CONV_W = 3
N_GATE = 4 * N_MLSTM_HEADS
D_FF = 4 * D_MODEL
D_PLE = 256
RMS_EPS = 1e-6
SPLITS = (D_MLSTM, D_MLSTM, D_MLSTM, D_MLSTM, N_GATE, D_NA, D_NA, D_NA)
D_IN_PROJ = sum(SPLITS)

kernel_name = "hybrid_mlstm_natten_block"


def rms_norm(x, g):
    xf = x.astype(jnp.float32)
    y = xf * lax.rsqrt(jnp.mean(xf * xf, axis=-1, keepdims=True) + RMS_EPS)
    return (y * g.astype(jnp.float32)).astype(x.dtype)


def centred_depthwise_conv(x, w, b):
    c = x.shape[-1]
    y = lax.conv_general_dilated(x, w[:, None, :].astype(x.dtype), window_strides=(1,), padding='SAME',
                                 dimension_numbers=('NWC', 'WIO', 'NWC'), feature_group_count=c)
    return y + b.astype(x.dtype)


def mlstm_chunkwise(q, k, v, log_i, log_f):
    B, H, S, d = q.shape
    nc = S // CHUNK

    def to_chunks(a):
        a = a.reshape(B, H, nc, CHUNK, *a.shape[3:])
        return jnp.moveaxis(a, 2, 0)

    f32 = jnp.float32
    xs = (to_chunks(q.astype(f32)), to_chunks(k.astype(f32)), to_chunks(v.astype(f32)),
          to_chunks(log_i), to_chunks(log_f))
    tri = jnp.tril(jnp.ones((CHUNK, CHUNK), dtype=bool))

    def step(carry, inp):
        C, n, m = carry
        qb, kb, vb, ib, fb = inp
        b = jnp.cumsum(fb, axis=-1)
        g = b + m[..., None]
        dmat = jnp.where(tri, b[..., :, None] - b[..., None, :] + ib[..., None, :], -jnp.inf)
        m_t = jnp.maximum(g, jnp.max(dmat, axis=-1))
        w_inter = jnp.exp(g - m_t)
        s = jnp.einsum('bhld,bhsd->bhls', qb, kb) * jnp.exp(dmat - m_t[..., None])
        num = w_inter[..., None] * jnp.einsum('bhld,bhde->bhle', qb, C) + jnp.einsum('bhls,bhse->bhle', s, vb)
        den = w_inter * jnp.einsum('bhld,bhd->bhl', qb, n) + jnp.sum(s, axis=-1)
        h = num / jnp.maximum(jnp.abs(den), jnp.exp(-m_t))[..., None]
        b_last = b[..., -1]
        a_prev = m + b_last
        a_j = ib + b_last[..., None] - b
        m_new = jnp.maximum(a_prev, jnp.max(a_j, axis=-1))
        w_prev = jnp.exp(a_prev - m_new)
        w_j = jnp.exp(a_j - m_new[..., None])
        C_new = w_prev[..., None, None] * C + jnp.einsum('bhs,bhsd,bhse->bhde', w_j, kb, vb)
        n_new = w_prev[..., None] * n + jnp.einsum('bhs,bhsd->bhd', w_j, kb)
        return (C_new, n_new, m_new), h

    init = (jnp.zeros((B, H, d, d), f32), jnp.zeros((B, H, d), f32), jnp.zeros((B, H), f32))
    _, hs = lax.scan(step, init, xs)
    return jnp.moveaxis(hs, 0, 2).reshape(B, H, S, d).astype(q.dtype)


def mlstm_mixer(q_raw, k_raw, v, o_pre, gate_pre, conv_w, conv_b, gate_b, head_norm_g):
    B, S, _ = v.shape
    qk = jax.nn.silu(centred_depthwise_conv(jnp.concatenate([q_raw, k_raw], axis=-1), conv_w, conv_b))
    q, k = jnp.split(qk, 2, axis=-1)

    def heads(a):
        return a.reshape(B, S, N_MLSTM_HEADS, MLSTM_HEAD_DIM).transpose(0, 2, 1, 3)

    q, k, vh = heads(q), heads(k) * (MLSTM_HEAD_DIM ** -0.5), heads(v)
    gates = (gate_pre.astype(jnp.float32) + gate_b.astype(jnp.float32))
    gates = gates.reshape(B, S, 4, N_MLSTM_HEADS).transpose(2, 0, 3, 1)
    i_fwd, f_fwd, i_bwd, f_bwd = gates[0], gates[1], gates[2], gates[3]
    h_fwd = mlstm_chunkwise(q, k, vh, i_fwd, jax.nn.log_sigmoid(f_fwd))
    flip = lambda a: jnp.flip(a, axis=2)
    h_bwd = flip(mlstm_chunkwise(flip(q), flip(k), flip(vh), flip(i_bwd), flip(jax.nn.log_sigmoid(f_bwd))))
    h = (h_fwd + h_bwd).transpose(0, 2, 1, 3)
    h = rms_norm(h, head_norm_g).reshape(B, S, D_MLSTM)
    return h * jax.nn.sigmoid(o_pre)


def neighbourhood_attention(q, k, v, q_norm_g, k_norm_g, rpb):
    B, S, _ = q.shape
    rows = S // GRID_W
    win_h = min(WIN_H_MAX, rows)

    def grid(a):
        return a.reshape(B, rows, GRID_W, N_NA_HEADS, NA_HEAD_DIM).transpose(0, 3, 1, 2, 4)

    split_heads = lambda a: a.reshape(B, S, N_NA_HEADS, NA_HEAD_DIM)
    qg = grid(rms_norm(split_heads(q), q_norm_g) * (NA_HEAD_DIM ** -0.5))
    kg = grid(rms_norm(split_heads(k), k_norm_g))
    vg = grid(split_heads(v))

    cols = jnp.arange(GRID_W)
    col_start = jnp.clip(cols - WIN_W // 2, 0, GRID_W - WIN_W)
    col_idx = col_start[:, None] + jnp.arange(WIN_W)
    col_off = col_idx - cols[:, None] + (WIN_W - 1)

    def one_row(r):
        rs = jnp.clip(r - win_h // 2, 0, rows - win_h)
        k_win = lax.dynamic_slice_in_dim(kg, rs, win_h, axis=2)[:, :, :, col_idx]
        v_win = lax.dynamic_slice_in_dim(vg, rs, win_h, axis=2)[:, :, :, col_idx]
        q_row = lax.dynamic_index_in_dim(qg, r, axis=2, keepdims=False)
        s = jnp.einsum('bhcd,bhrcwd->bhcrw', q_row, k_win).astype(jnp.float32)
        row_off = rs + jnp.arange(win_h) - r + (WIN_H_MAX - 1)
        bias = rpb[:, row_off][:, :, col_off].astype(jnp.float32)
        s = s + bias.transpose(0, 2, 1, 3)[None]
        prob = jax.nn.softmax(s.reshape(B, N_NA_HEADS, GRID_W, win_h * WIN_W), axis=-1)
        prob = prob.reshape(B, N_NA_HEADS, GRID_W, win_h, WIN_W).astype(v.dtype)
        return jnp.einsum('bhcrw,bhrcwd->bhcd', prob, v_win)

    out = lax.map(one_row, jnp.arange(rows))
    return out.transpose(1, 0, 3, 2, 4).reshape(B, S, D_NA)


def setup_inputs(seed: int = 0) -> dict:
    key = jax.random.key(seed)
    ks = jax.random.split(key, 20)
    nrm = lambda k, shape: jax.random.normal(k, shape, dtype=jnp.float32)
    H = N_MLSTM_HEADS
    f_bias = jnp.tile(jnp.linspace(3.0, 6.0, H, dtype=jnp.float32), 2)
    gate_base = jnp.stack([jnp.zeros((H,), jnp.float32), f_bias[:H], jnp.zeros((H,), jnp.float32), f_bias[H:]]).reshape(-1)
    return {
        "x": nrm(ks[0], (BATCH, SEQ, D_MODEL)),
        "p": nrm(ks[1], (DEPTH, BATCH, SEQ, D_PLE)),
        "norm1_g": 1.0 + 0.01 * nrm(ks[2], (DEPTH, D_MODEL)),
        "w_in": nrm(ks[3], (DEPTH, D_MODEL, D_IN_PROJ)) * D_MODEL ** -0.5,
        "conv_w": nrm(ks[4], (DEPTH, CONV_W, 2 * D_MLSTM)) * CONV_W ** -0.5,
        "conv_b": 0.01 * nrm(ks[5], (DEPTH, 2 * D_MLSTM)),
        "gate_b": gate_base[None] + 0.1 * nrm(ks[6], (DEPTH, N_GATE)),
        "mlstm_norm_g": 1.0 + 0.01 * nrm(ks[7], (DEPTH, N_MLSTM_HEADS, MLSTM_HEAD_DIM)),
        "q_norm_g": 1.0 + 0.01 * nrm(ks[8], (DEPTH, N_NA_HEADS, NA_HEAD_DIM)),
        "k_norm_g": 1.0 + 0.01 * nrm(ks[9], (DEPTH, N_NA_HEADS, NA_HEAD_DIM)),
        "rpb": 0.02 * nrm(ks[10], (DEPTH, N_NA_HEADS, 2 * WIN_H_MAX - 1, 2 * WIN_W - 1)),
        "w_out": nrm(ks[11], (DEPTH, D_MIX, D_MODEL)) * D_MIX ** -0.5,
        "norm2_g": 1.0 + 0.01 * nrm(ks[12], (DEPTH, D_MODEL)),
        "w_ff1": nrm(ks[13], (DEPTH, D_MODEL, D_FF)) * D_MODEL ** -0.5,
        "w_ff2": nrm(ks[14], (DEPTH, D_FF, D_MODEL)) * D_FF ** -0.5,
        "ple_norm_g": 1.0 + 0.01 * nrm(ks[15], (DEPTH, D_MODEL)),
        "w_ple_gate": nrm(ks[16], (DEPTH, D_MODEL, D_MODEL)) * D_MODEL ** -0.5,
        "w_ple_up": nrm(ks[17], (DEPTH, D_PLE, D_MODEL)) * D_PLE ** -0.5,
    }


def reference(x, p, norm1_g, w_in, conv_w, conv_b, gate_b, mlstm_norm_g, q_norm_g, k_norm_g, rpb,
              w_out, norm2_g, w_ff1, w_ff2, ple_norm_g, w_ple_gate, w_ple_up):
    h = x
    offsets = list(np.cumsum(SPLITS)[:-1])
    for i in range(DEPTH):
        u = rms_norm(h, norm1_g[i])
        proj = jnp.einsum('bsd,de->bse', u, w_in[i])
        mq, mk, mv, mo, mg, nq, nk, nv = jnp.split(proj, offsets, axis=-1)
        y_a = mlstm_mixer(mq, mk, mv, mo, mg, conv_w[i], conv_b[i], gate_b[i], mlstm_norm_g[i])
        y_b = neighbourhood_attention(nq, nk, nv, q_norm_g[i], k_norm_g[i], rpb[i])
        h = h + jnp.einsum('bse,ed->bsd', jnp.concatenate([y_a, y_b], axis=-1), w_out[i])
        z = jnp.einsum('bsd,df->bsf', rms_norm(h, norm2_g[i]), w_ff1[i])
        h = h + jnp.einsum('bsf,fd->bsd', jnp.square(jax.nn.relu(z)), w_ff2[i])
        gate = jax.nn.sigmoid(jnp.einsum('bsd,de->bse', rms_norm(h, ple_norm_g[i]), w_ple_gate[i]))
        h = h + gate * jnp.einsum('bsk,kd->bsd', p[i], w_ple_up[i])
    return h
```

```cpp
#include <hip/hip_runtime.h>
#include <hip/hip_cooperative_groups.h>
#include <cstdio>
#include <cstdint>
#include <cmath>
namespace cg = cooperative_groups;
namespace pg8 {
#define PG8_LAS __attribute__((address_space(3)))
typedef unsigned short bf16_t;
typedef short bf16x8 __attribute__((ext_vector_type(8)));
typedef float f32x4 __attribute__((ext_vector_type(4)));
typedef unsigned u32x4 __attribute__((ext_vector_type(4)));
constexpr int BM = 256, BK = 64, HALF = 128, HTB = HALF * BK * 2  , STAGE_BYTES = 8 * HTB, NXCD = 8, WGM = 8;

__host__ __device__ __forceinline__ int lds_byte(int r, int c) { const int st = (r >> 4) * 2 + (c >> 5), rr = r & 15, cc = c & 31, ob = rr * 64 + cc * 2; return st * 1024 + (ob ^ (((ob >> 9) & 1) << 5)); }
__host__ __device__ __forceinline__ void stage_rc(int b, int& R, int& C) { const int st = b / 1024, sb = b % 1024, swz = sb ^ (((sb >> 9) & 1) << 5); R = (st >> 1) * 16 + swz / 64; C = (st & 1) * 32 + (swz % 64) / 2; }
__host__ __device__ __forceinline__ int perm32(int rho) { const int n = rho >> 4, i = rho & 15; return 8 * (i >> 2) + 4 * n + (i & 3); }

struct Unit { int pm, pn; };
struct Gemm { const bf16_t* A; const bf16_t* Bt; int M, N, K; };

struct StaticOrder {
    int nM, nN, nwg, G, c;
    __host__ __device__ void init(int M, int N, int G_, int c_) { nM = M / BM; nN = N / BM; nwg = nM * nN; G = G_; c = c_; }
    __host__ __device__ bool next(int i, Unit& u) const {
        const long L = (long)i * G + c; if (L >= nwg) return false;
        int wgid = (int)L; { const int q = nwg / NXCD, r = nwg % NXCD, xcd = wgid % NXCD, off = wgid / NXCD; wgid = (xcd < r ? xcd * (q + 1) : r * (q + 1) + (xcd - r) * q) + off; }
        const int nig = WGM * nN, gid = wgid / nig, fm = gid * WGM, gsz = (nM - fm) < WGM ? (nM - fm) : WGM;
        u.pm = fm + ((wgid % nig) % gsz); u.pn = (wgid % nig) / gsz; return true;
    }
    __device__ __forceinline__ void a_ready(const Unit&) const {}
    __device__ __forceinline__ void done(const Unit&) const {}
};
typedef float cvt_f32x2 __attribute__((ext_vector_type(2)));
typedef __bf16 cvt_bf16x2 __attribute__((ext_vector_type(2)));
__device__ __forceinline__ unsigned cvt_pk_bf16(float lo, float hi) { const cvt_f32x2 v = {lo, hi}; const cvt_bf16x2 b = __builtin_convertvector(v, cvt_bf16x2); return __builtin_bit_cast(unsigned, b); }
typedef float f32x2 __attribute__((ext_vector_type(2)));
template <class Epi, class Sched, bool ALIGN_EPI = false, bool SP2 = false>
__device__ __forceinline__ void gemm_phase(PG8_LAS unsigned char* lds, const Gemm g, const Sched& S, const Epi& E, int tid_in) {
    int tid_raw = tid_in; asm volatile("" : "+v"(tid_raw));
    const int tid = tid_raw, wid = __builtin_amdgcn_readfirstlane(tid >> 6), lane = tid & 63, wr = wid >> 2, wc = wid & 3, fr = lane & 15, fq = lane >> 4;
    const int K = g.K, nt = K / BK;
    unsigned voffA[2], voffB[2];
#pragma unroll
    for (int i = 0; i < 2; ++i) { int R, C; stage_rc(tid * 16 + i * 8192, R, C); const int Rb = Epi::PERM ? ((R & ~31) + perm32(R & 31)) : R;
        voffA[i] = (unsigned)(R * K + C) * 2u; voffB[i] = (unsigned)(Rb * K + C) * 2u; }
    const size_t kstep = (size_t)(BK * 2);
    const size_t hstep = (size_t)HALF * K * 2;
    const size_t tstep = 2 * hstep;
    const unsigned ldsw = (unsigned)wid * 1024u;
    const int aoff = lds_byte(wr * 64 + fr, fq * 8), boff = lds_byte(wc * 32 + fr, fq * 8);
#define PG8_SA(b, h) (((b) * 2 + (h)) * HTB)
#define PG8_SB(b, h) ((4 + (b) * 2 + (h)) * HTB)
#define PG8_STAGE(bufoff, gbase, voff) do { _Pragma("unroll") for (int _i = 0; _i < 2; ++_i) \
        __builtin_amdgcn_global_load_lds((const unsigned*)((const char*)(gbase) + (voff)[_i]), (PG8_LAS unsigned*)(lds + (bufoff) + ldsw + _i * 8192), 16, 0, 0); } while (0)
#define PG8_LDA(dst, b, h) do { _Pragma("unroll") for (int m = 0; m < 4; ++m) _Pragma("unroll") for (int k = 0; k < 2; ++k) dst[m][k] = *(const PG8_LAS bf16x8*)(lds + PG8_SA(b, h) + aoff + m * 2048 + k * 1024); } while (0)
#define PG8_LDB(dst, b, h) do { _Pragma("unroll") for (int n = 0; n < 2; ++n) _Pragma("unroll") for (int k = 0; k < 2; ++k) dst[n][k] = *(const PG8_LAS bf16x8*)(lds + PG8_SB(b, h) + boff + n * 2048 + k * 1024); } while (0)
#define PG8_MMA(ai, bj, At, Bt) do { __builtin_amdgcn_s_setprio(1); _Pragma("unroll") for (int m = 0; m < 4; ++m) _Pragma("unroll") for (int n = 0; n < 2; ++n) _Pragma("unroll") for (int k = 0; k < 2; ++k) \
        acc[ai][bj][m][n] = __builtin_amdgcn_mfma_f32_16x16x32_bf16(Bt[n][k], At[m][k], acc[ai][bj][m][n], 0, 0, 0); __builtin_amdgcn_s_setprio(0); } while (0)
#define PG8_WAIT_V(n) asm volatile("s_waitcnt vmcnt(" #n ")" ::: "memory")
#define PG8_WAIT_L(n) asm volatile("s_waitcnt lgkmcnt(" #n ")" ::: "memory")
#define PG8_BAR __builtin_amdgcn_s_barrier()
#define PG8_SCHED __builtin_amdgcn_sched_barrier(0)
    Unit cur, nxt; int ui = 0;
    if (!S.next(0, cur)) return;
    f32x4 acc[2][2][4][2];
#pragma unroll
    for (int a = 0; a < 2; ++a)
#pragma unroll
        for (int b = 0; b < 2; ++b)
#pragma unroll
            for (int m = 0; m < 4; ++m)
#pragma unroll
                for (int n = 0; n < 2; ++n) acc[a][b][m][n] = (f32x4){0.f, 0.f, 0.f, 0.f};
    bf16x8 At[4][2], B0[2][2], B1[2][2];
    const char* cA = (const char*)g.A + (size_t)cur.pm * tstep; const char* cB = (const char*)g.Bt + (size_t)cur.pn * tstep;
    S.a_ready(cur);
    if constexpr (SP2) {
        PG8_STAGE(PG8_SB(0, 0), cB, voffB); PG8_STAGE(PG8_SB(0, 1), cB + hstep, voffB); PG8_STAGE(PG8_SA(0, 0), cA, voffA); PG8_STAGE(PG8_SA(0, 1), cA + hstep, voffA);
        if (wr == 1) PG8_BAR;
        PG8_WAIT_V(2); PG8_BAR;
        PG8_STAGE(PG8_SB(1, 0), cB + kstep, voffB); PG8_STAGE(PG8_SA(1, 0), cA + kstep, voffA); PG8_STAGE(PG8_SB(1, 1), cB + hstep + kstep, voffB);
        PG8_WAIT_V(6); PG8_BAR;
    } else {
        PG8_STAGE(PG8_SB(0, 0), cB, voffB); PG8_STAGE(PG8_SA(0, 0), cA, voffA); PG8_STAGE(PG8_SB(0, 1), cB + hstep, voffB); PG8_STAGE(PG8_SA(0, 1), cA + hstep, voffA);
        if (wr == 1) PG8_BAR;
        PG8_WAIT_V(4); PG8_BAR;
        PG8_STAGE(PG8_SB(1, 0), cB + kstep, voffB); PG8_STAGE(PG8_SA(1, 0), cA + kstep, voffA); PG8_STAGE(PG8_SB(1, 1), cB + hstep + kstep, voffB);
        PG8_WAIT_V(6); PG8_BAR;
    }
    for (;;) {
        const bool has_next = S.next(ui + 1, nxt);
        const char* nA = has_next ? (const char*)g.A + (size_t)nxt.pm * tstep : cA; const char* nB = has_next ? (const char*)g.Bt + (size_t)nxt.pn * tstep : cB;
        for (int t = 0; t < nt; t += 2) {
            const bool last = (t == nt - 2);
            const char* a1 = cA + (size_t)(t + 1) * kstep;
            const char* a2 = last ? nA : cA + (size_t)(t + 2) * kstep; const char* b2 = last ? nB : cB + (size_t)(t + 2) * kstep;
            const char* a3 = a2 + kstep; const char* b3 = b2 + kstep;
            if (last && has_next) S.a_ready(nxt);
            if constexpr (SP2) {
            PG8_LDB(B0, 0, 0); PG8_LDB(B1, 0, 1); PG8_SCHED; PG8_LDA(At, 0, 0); PG8_STAGE(PG8_SA(1, 1), a1 + hstep, voffA);
            PG8_WAIT_V(8); PG8_WAIT_L(0); PG8_BAR; PG8_MMA(0, 0, At, B0); PG8_MMA(0, 1, At, B1); PG8_BAR; PG8_SCHED;
            PG8_LDA(At, 0, 1); PG8_STAGE(PG8_SB(0, 0), b2, voffB); PG8_STAGE(PG8_SB(0, 1), b2 + hstep, voffB); PG8_STAGE(PG8_SA(0, 0), a2, voffA);
            PG8_WAIT_V(8); PG8_WAIT_L(0); PG8_BAR; PG8_MMA(1, 0, At, B0); PG8_MMA(1, 1, At, B1); PG8_BAR; PG8_SCHED;
            PG8_LDB(B0, 1, 0); PG8_LDB(B1, 1, 1); PG8_SCHED; PG8_LDA(At, 1, 0); PG8_STAGE(PG8_SA(0, 1), a2 + hstep, voffA);
            PG8_WAIT_V(8); PG8_WAIT_L(0); PG8_BAR; PG8_MMA(0, 0, At, B0); PG8_MMA(0, 1, At, B1); PG8_BAR; PG8_SCHED;
            PG8_LDA(At, 1, 1); PG8_STAGE(PG8_SB(1, 0), b3, voffB); PG8_STAGE(PG8_SB(1, 1), b3 + hstep, voffB); PG8_STAGE(PG8_SA(1, 0), a3, voffA);
            PG8_WAIT_V(8); PG8_WAIT_L(0); PG8_BAR; PG8_MMA(1, 0, At, B0); PG8_MMA(1, 1, At, B1); PG8_BAR; PG8_SCHED;
            } else {
            PG8_LDB(B0, 0, 0); PG8_SCHED; PG8_LDA(At, 0, 0); PG8_STAGE(PG8_SA(1, 1), a1 + hstep, voffA);
            PG8_WAIT_L(8); PG8_BAR; PG8_WAIT_L(0); PG8_MMA(0, 0, At, B0); PG8_BAR; PG8_SCHED;
            PG8_LDB(B1, 0, 1); PG8_STAGE(PG8_SB(0, 0), b2, voffB);
            PG8_BAR; PG8_WAIT_L(0); PG8_MMA(0, 1, At, B1); PG8_BAR;
            PG8_LDA(At, 0, 1); PG8_STAGE(PG8_SA(0, 0), a2, voffA);
            PG8_BAR; PG8_WAIT_L(0); PG8_MMA(1, 0, At, B0); PG8_BAR; PG8_SCHED;
            PG8_STAGE(PG8_SB(0, 1), b2 + hstep, voffB);
            PG8_WAIT_V(6); PG8_BAR; PG8_MMA(1, 1, At, B1); PG8_BAR;
            PG8_LDB(B0, 1, 0); PG8_SCHED; PG8_LDA(At, 1, 0); PG8_STAGE(PG8_SA(0, 1), a2 + hstep, voffA);
            PG8_WAIT_L(8); PG8_BAR; PG8_WAIT_L(0); PG8_MMA(0, 0, At, B0); PG8_BAR; PG8_SCHED;
            PG8_LDB(B1, 1, 1); PG8_STAGE(PG8_SB(1, 0), b3, voffB);
            PG8_BAR; PG8_WAIT_L(0); PG8_MMA(0, 1, At, B1); PG8_BAR;
            PG8_LDA(At, 1, 1); PG8_STAGE(PG8_SA(1, 0), a3, voffA);
            PG8_BAR; PG8_WAIT_L(0); PG8_MMA(1, 0, At, B0); PG8_BAR; PG8_SCHED;
            PG8_STAGE(PG8_SB(1, 1), b3 + hstep, voffB);
            PG8_WAIT_V(6); PG8_BAR; PG8_MMA(1, 1, At, B1); PG8_BAR;
            }
        }
        if constexpr (ALIGN_EPI) { if (wr == 0) PG8_BAR; }
        if constexpr (!Epi::AFTER_DRAIN) { E(acc, cur, wr, wc, fr, fq); S.done(cur); }
        if (!has_next) break;
#pragma unroll
        for (int a = 0; a < 2; ++a)
#pragma unroll
            for (int b = 0; b < 2; ++b)
#pragma unroll
                for (int m = 0; m < 4; ++m)
#pragma unroll
                    for (int n = 0; n < 2; ++n) acc[a][b][m][n] = (f32x4){0.f, 0.f, 0.f, 0.f};
        cur = nxt; cA = nA; cB = nB; ++ui;
        if constexpr (ALIGN_EPI) { if (wr == 1) PG8_BAR; }
    }
    PG8_WAIT_V(0);
    if constexpr (!ALIGN_EPI) { if (wr == 0) PG8_BAR; }
    PG8_BAR;
    if constexpr (Epi::AFTER_DRAIN) { E.fused(acc, cur, wr, wc, fr, fq, lds, wid, lane); S.done(cur); }
#undef PG8_SA
#undef PG8_SB
#undef PG8_STAGE
#undef PG8_LDA
#undef PG8_LDB
#undef PG8_MMA
#undef PG8_WAIT_V
#undef PG8_WAIT_L
#undef PG8_BAR
#undef PG8_SCHED
}
}

#define LAS __attribute__((address_space(3)))
typedef unsigned short bf16_t;
typedef short bf16x8 __attribute__((ext_vector_type(8)));
typedef float f32x4 __attribute__((ext_vector_type(4)));
typedef unsigned u32x4 __attribute__((ext_vector_type(4)));
typedef unsigned u32x2 __attribute__((ext_vector_type(2)));
using pg8::cvt_pk_bf16;

constexpr int M = 16384, SEQ = 8192, DM = 1024, DFF = 4096, DPLE = 256;
constexpr int NPROJ = 3840, PROJ_LD = 3072, NIN = 3600;
constexpr float RMS_EPS = 1e-6f;
constexpr int NTHREADS = 512, NWAVES = 8;
constexpr int LDS_BYTES = 163840;

constexpr size_t KiB = 1024, MiB = 1u << 20;
constexpr size_t WS_ROWSQ1 = 0, WS_ROWSQ2 = 64 * KiB, WS_FC = 128 * KiB, WS_MLOC = 132 * KiB, WS_MSTART = 136 * KiB;
constexpr size_t WS_BAR = 144 * KiB;
constexpr size_t WS_NLOC = 256 * KiB, WS_NSTART = 768 * KiB;
constexpr size_t WS_WIN = 2 * MiB, WS_WOUT = WS_WIN + (size_t)NPROJ * DM * 2, WS_WFF1 = WS_WOUT + 2 * MiB, WS_WFF2 = WS_WFF1 + 8 * MiB,
                 WS_WPG = WS_WFF2 + 8 * MiB, WS_WPU = WS_WPG + 2 * MiB;
constexpr size_t WS_XN = 30 * MiB;
constexpr size_t WS_PU = 62 * MiB, WS_Y = 94 * MiB, WS_HID = 126 * MiB;
constexpr size_t WS_PROJ = 126 * MiB, WS_VTN = 222 * MiB, WS_PB = 238 * MiB, WS_GATES = 246 * MiB, WS_END = 254 * MiB;
static_assert(WS_WPU + 512 * KiB <= WS_XN, "weights fit");

struct Params { const float* in[18]; float* out; unsigned char* ws; };
enum { I_X = 0, I_P, I_N1G, I_WIN, I_CONVW, I_CONVB, I_GATEB, I_MNG, I_QNG, I_KNG, I_RPB, I_WOUT, I_N2G, I_WFF1, I_WFF2, I_PNG, I_WPG, I_WPU };

__device__ __forceinline__ float bflo(unsigned u) { return __uint_as_float(u << 16); }
__device__ __forceinline__ float bfhi(unsigned u) { return __uint_as_float(u & 0xffff0000u); }
__device__ __forceinline__ unsigned short f2bf(float f) { return (unsigned short)(cvt_pk_bf16(f, 0.f) & 0xffffu); }
__device__ __forceinline__ float sigmoidf_(float x) { return __builtin_amdgcn_rcpf(1.0f + __expf(-x)); }
__device__ __forceinline__ float wave_sum_all(float v) {
#pragma unroll
    for (int o = 1; o < 64; o <<= 1) v += __shfl_xor(v, o);
    return v;
}
__device__ __forceinline__ float wave_max_all(float v) {
#pragma unroll
    for (int o = 1; o < 64; o <<= 1) v = fmaxf(v, __shfl_xor(v, o));
    return v;
}
__device__ __forceinline__ float wave_incl_sum(float v, int lane) {
#pragma unroll
    for (int o = 1; o < 64; o <<= 1) { float t = __shfl_up(v, o); if (lane >= o) v += t; }
    return v;
}
__device__ __forceinline__ float wave_incl_max(float v, int lane) {
#pragma unroll
    for (int o = 1; o < 64; o <<= 1) { float t = __shfl_up(v, o); if (lane >= o) v = fmaxf(v, t); }
    return v;
}

#ifndef EPI_NT
#define EPI_NT 0
#endif
#if EPI_NT
#define EPI_ST16(p, v) __builtin_nontemporal_store((v), (u32x4*)(p))
#define EPI_ST8(p, v) __builtin_nontemporal_store((v), (u32x2*)(p))
#else
#define EPI_ST16(p, v) (*(u32x4*)(p) = (v))
#define EPI_ST8(p, v) (*(u32x2*)(p) = (v))
#endif
struct EpiInProj {
    static constexpr bool PERM = true, AFTER_DRAIN = false;
    bf16_t* proj; bf16_t* vtn; float* gates; const float* gate_b;
    __device__ __forceinline__ void operator()(const f32x4 (&acc)[2][2][4][2], const pg8::Unit& u, int wr, int wc, int fr, int fq) const {
        const int row0 = u.pm * 256 + wr * 64 + fr;
        if (u.pn < 12) {
            const int col0 = u.pn * 256 + wc * 32 + 8 * fq;
#pragma unroll
            for (int ai = 0; ai < 2; ++ai)
#pragma unroll
                for (int m = 0; m < 4; ++m) { bf16_t* rowp = proj + (size_t)(row0 + ai * 128 + m * 16) * PROJ_LD + col0;
#pragma unroll
                    for (int bj = 0; bj < 2; ++bj) { const f32x4 v0 = acc[ai][bj][m][0], v1 = acc[ai][bj][m][1]; u32x4 w;
                        w.x = cvt_pk_bf16(v0[0], v0[1]); w.y = cvt_pk_bf16(v0[2], v0[3]); w.z = cvt_pk_bf16(v1[0], v1[1]); w.w = cvt_pk_bf16(v1[2], v1[3]);
                        EPI_ST16(rowp + bj * 128, w); } }
        } else if (u.pn < 14) {
            const int b = row0 >> 13, s0 = row0 & 8191;
            bf16_t* vb = vtn + ((size_t)(b * 512 + (u.pn - 12) * 256 + wc * 32 + 8 * fq)) * SEQ + s0;
#pragma unroll
            for (int bj = 0; bj < 2; ++bj)
#pragma unroll
                for (int n = 0; n < 2; ++n)
#pragma unroll
                    for (int i = 0; i < 4; ++i) { bf16_t* vp = vb + (size_t)(bj * 128 + 4 * n + i) * SEQ;
#pragma unroll
                        for (int ai = 0; ai < 2; ++ai)
#pragma unroll
                            for (int m = 0; m < 4; ++m) vp[ai * 128 + m * 16] = f2bf(acc[ai][bj][m][n][i]); }
        } else {
            if (wc == 0 && fq < 2) {
#pragma unroll
                for (int ai = 0; ai < 2; ++ai)
#pragma unroll
                    for (int m = 0; m < 4; ++m) { const int row = row0 + ai * 128 + m * 16;
#pragma unroll
                        for (int n = 0; n < 2; ++n) { f32x4 o;
#pragma unroll
                            for (int i = 0; i < 4; ++i) { const int c = 8 * fq + 4 * n + i; float v = acc[ai][0][m][n][i] + gate_b[c];
                                if ((c >> 2) & 1) v = fminf(v, 0.f) - log1pf(__expf(-fabsf(v)));
                                o[i] = v; }
                            *(f32x4*)(gates + (size_t)row * 16 + 8 * fq + 4 * n) = o; } }
            }
        }
    }
};
struct EpiBf16Plain {
    static constexpr bool PERM = true, AFTER_DRAIN = false;
    bf16_t* O; int ldc;
    __device__ __forceinline__ void operator()(const f32x4 (&acc)[2][2][4][2], const pg8::Unit& u, int wr, int wc, int fr, int fq) const {
        const int row0 = u.pm * 256 + wr * 64 + fr, col0 = u.pn * 256 + wc * 32 + 8 * fq;
#pragma unroll
        for (int ai = 0; ai < 2; ++ai)
#pragma unroll
            for (int m = 0; m < 4; ++m) { bf16_t* rowp = O + (size_t)(row0 + ai * 128 + m * 16) * ldc + col0;
#pragma unroll
                for (int bj = 0; bj < 2; ++bj) { const f32x4 v0 = acc[ai][bj][m][0], v1 = acc[ai][bj][m][1]; u32x4 w;
                    w.x = cvt_pk_bf16(v0[0], v0[1]); w.y = cvt_pk_bf16(v0[2], v0[3]); w.z = cvt_pk_bf16(v1[0], v1[1]); w.w = cvt_pk_bf16(v1[2], v1[3]);
                    __builtin_nontemporal_store(w, (u32x4*)(rowp + bj * 128)); } }
    }
};
struct EpiRelu2 {
    static constexpr bool PERM = true, AFTER_DRAIN = false;
    bf16_t* O; const float* rowsq;
    __device__ __forceinline__ void operator()(const f32x4 (&acc)[2][2][4][2], const pg8::Unit& u, int wr, int wc, int fr, int fq) const {
        const int row0 = u.pm * 256 + wr * 64 + fr, col0 = u.pn * 256 + wc * 32 + 8 * fq;
#pragma unroll
        for (int ai = 0; ai < 2; ++ai)
#pragma unroll
            for (int m = 0; m < 4; ++m) { const int row = row0 + ai * 128 + m * 16; bf16_t* rowp = O + (size_t)row * DFF + col0;
                const float r2 = __builtin_amdgcn_rcpf(rowsq[row] * (1.0f / DM) + RMS_EPS);
#pragma unroll
                for (int bj = 0; bj < 2; ++bj) { f32x4 v0 = acc[ai][bj][m][0], v1 = acc[ai][bj][m][1];
#pragma unroll
                    for (int i = 0; i < 4; ++i) { float a = fmaxf(v0[i], 0.f), b = fmaxf(v1[i], 0.f); v0[i] = a * a * r2; v1[i] = b * b * r2; }
                    u32x4 w; w.x = cvt_pk_bf16(v0[0], v0[1]); w.y = cvt_pk_bf16(v0[2], v0[3]); w.z = cvt_pk_bf16(v1[0], v1[1]); w.w = cvt_pk_bf16(v1[2], v1[3]);
                    EPI_ST16(rowp + bj * 128, w); } }
    }
};
struct EpiResid {
    static constexpr bool PERM = true, AFTER_DRAIN = false;
    const float* base; const bf16_t* baseb; bf16_t* outb; float* rowsq;
    __device__ __forceinline__ void operator()(const f32x4 (&acc)[2][2][4][2], const pg8::Unit& u, int wr, int wc, int fr, int fq) const {
        const int row0 = u.pm * 256 + wr * 64 + fr, col0 = u.pn * 256 + wc * 32 + 8 * fq;
#pragma unroll
        for (int ai = 0; ai < 2; ++ai)
#pragma unroll
            for (int m = 0; m < 4; ++m) { const int row = row0 + ai * 128 + m * 16; const size_t off = (size_t)row * DM + col0; float ss = 0.f;
#pragma unroll
                for (int bj = 0; bj < 2; ++bj) { const size_t o2 = off + bj * 128; f32x4 b0, b1;
                    if (base) { b0 = __builtin_nontemporal_load((const f32x4*)(base + o2)); b1 = __builtin_nontemporal_load((const f32x4*)(base + o2 + 4)); }
                    else { const u32x4 bw = __builtin_nontemporal_load((const u32x4*)(baseb + o2)); b0 = (f32x4){bflo(bw.x), bfhi(bw.x), bflo(bw.y), bfhi(bw.y)}; b1 = (f32x4){bflo(bw.z), bfhi(bw.z), bflo(bw.w), bfhi(bw.w)}; }
                    const f32x4 o0 = b0 + acc[ai][bj][m][0], o1 = b1 + acc[ai][bj][m][1];
                    u32x4 w; w.x = cvt_pk_bf16(o0[0], o0[1]); w.y = cvt_pk_bf16(o0[2], o0[3]); w.z = cvt_pk_bf16(o1[0], o1[1]); w.w = cvt_pk_bf16(o1[2], o1[3]); *(u32x4*)(outb + o2) = w;
                    ss += ((o0[0] * o0[0] + o0[1] * o0[1]) + (o0[2] * o0[2] + o0[3] * o0[3])) + ((o1[0] * o1[0] + o1[1] * o1[1]) + (o1[2] * o1[2] + o1[3] * o1[3])); }
                ss += __shfl_xor(ss, 16); ss += __shfl_xor(ss, 32);
                if (fq == 0) atomicAdd(rowsq + row, ss); }
    }
};
struct EpiPle {
    static constexpr bool PERM = true, AFTER_DRAIN = false;
    const bf16_t* h; float* out; const bf16_t* pu; const float* rowsq;
    __device__ __forceinline__ void operator()(const f32x4 (&acc)[2][2][4][2], const pg8::Unit& u, int wr, int wc, int fr, int fq) const {
        const int row0 = u.pm * 256 + wr * 64 + fr, col0 = u.pn * 256 + wc * 32 + 8 * fq;
#pragma unroll
        for (int ai = 0; ai < 2; ++ai)
#pragma unroll
            for (int m = 0; m < 4; ++m) { const int row = row0 + ai * 128 + m * 16; const size_t off = (size_t)row * DM + col0;
                const float r = rsqrtf(rowsq[row] * (1.0f / DM) + RMS_EPS);
#pragma unroll
                for (int bj = 0; bj < 2; ++bj) { const size_t o2 = off + bj * 128; const u32x4 hw = __builtin_nontemporal_load((const u32x4*)(h + o2)); const u32x4 pw = __builtin_nontemporal_load((const u32x4*)(pu + o2));
#pragma unroll
                    for (int n = 0; n < 2; ++n) { const f32x4 a = acc[ai][bj][m][n]; const unsigned h0 = n ? hw.z : hw.x, h1 = n ? hw.w : hw.y, p0 = n ? pw.z : pw.x, p1 = n ? pw.w : pw.y; f32x4 o;
                        o[0] = bflo(h0) + sigmoidf_(r * a[0]) * bflo(p0); o[1] = bfhi(h0) + sigmoidf_(r * a[1]) * bfhi(p0);
                        o[2] = bflo(h1) + sigmoidf_(r * a[2]) * bflo(p1); o[3] = bfhi(h1) + sigmoidf_(r * a[3]) * bfhi(p1);
                        __builtin_nontemporal_store(o, (f32x4*)(out + o2 + 4 * n)); } } }
    }
};

struct PuOrder {
    int c;
    __device__ __forceinline__ bool next(int i, pg8::Unit& u) const { if (c < 129) return false; const int idx = (c - 129) + 127 * i; if (idx >= 256) return false; u.pm = idx >> 2; u.pn = idx & 3; return true; }
    __device__ __forceinline__ void a_ready(const pg8::Unit&) const {}
    __device__ __forceinline__ void done(const pg8::Unit&) const {}
};
__device__ __forceinline__ void p0_transpose_item(const float* W, int ldw, int coff, int K, int nblk, const float* gain, bf16_t* WT, int row_off, LAS float* scr, int item, int lane) {
    const int kb = item / nblk, nb = item % nblk, k0 = 64 * kb, n0 = 32 * nb;
    float wv[32];
#pragma unroll
    for (int i = 0; i < 32; ++i) { const int kk = 2 * i + (lane >> 5); wv[i] = __builtin_nontemporal_load(W + (size_t)(k0 + kk) * ldw + coff + n0 + (lane & 31)); }
#pragma unroll
    for (int i = 0; i < 32; ++i) { const int kk = 2 * i + (lane >> 5); float v = wv[i]; if (gain) v *= gain[k0 + kk]; scr[kk * 33 + (lane & 31)] = v; }
    asm volatile("s_waitcnt lgkmcnt(0)" ::: "memory");
    const int c = lane & 7;
#pragma unroll
    for (int j = 0; j < 4; ++j) { const int n = (lane >> 3) + 8 * j; const LAS float* s = scr + (8 * c) * 33 + n;
        u32x4 o; o.x = cvt_pk_bf16(s[0 * 33], s[1 * 33]); o.y = cvt_pk_bf16(s[2 * 33], s[3 * 33]); o.z = cvt_pk_bf16(s[4 * 33], s[5 * 33]); o.w = cvt_pk_bf16(s[6 * 33], s[7 * 33]);
        *(u32x4*)(WT + (size_t)(row_off + n0 + n) * K + k0 + 8 * c) = o; }
    asm volatile("s_waitcnt lgkmcnt(0)" ::: "memory");
}
__device__ __forceinline__ void transposes_early(const Params& P, LAS float* scr, int gw, int NGW, int lane) {
    unsigned char* ws = P.ws;
    constexpr int I0 = 16 * 64, I1 = 16 * 48, I2 = 16, I7 = 4 * 32;
    for (int it = gw; it < I0 + I1 + I2 + I7; it += NGW) {
        int r = it;
        if (r < I0) { p0_transpose_item(P.in[I_WIN], NIN, 0, DM, 64, nullptr, (bf16_t*)(ws + WS_WIN), 0, scr, r, lane); continue; } r -= I0;
        if (r < I1) { p0_transpose_item(P.in[I_WIN], NIN, 2064, DM, 48, nullptr, (bf16_t*)(ws + WS_WIN), 2048, scr, r, lane); continue; } r -= I1;
        if (r < I2) { p0_transpose_item(P.in[I_WIN], NIN, 2048, DM, 1, nullptr, (bf16_t*)(ws + WS_WIN), 3584, scr, r, lane); continue; } r -= I2;
        p0_transpose_item(P.in[I_WPU], DM, 0, DPLE, 32, nullptr, (bf16_t*)(ws + WS_WPU), 0, scr, r, lane);
    }
}
__device__ __forceinline__ void transposes_late(const Params& P, LAS float* scr, int gw, int NGW, int lane) {
    unsigned char* ws = P.ws;
    constexpr int I3 = 16 * 32, I4 = 16 * 128, I5 = 64 * 32, I6 = 16 * 32;
    for (int it = gw; it < I3 + I4 + I5 + I6; it += NGW) {
        int r = it;
        if (r < I3) { p0_transpose_item(P.in[I_WOUT], DM, 0, DM, 32, nullptr, (bf16_t*)(ws + WS_WOUT), 0, scr, r, lane); continue; } r -= I3;
        if (r < I4) { p0_transpose_item(P.in[I_WFF1], DFF, 0, DM, 128, P.in[I_N2G], (bf16_t*)(ws + WS_WFF1), 0, scr, r, lane); continue; } r -= I4;
        if (r < I5) { p0_transpose_item(P.in[I_WFF2], DM, 0, DFF, 32, nullptr, (bf16_t*)(ws + WS_WFF2), 0, scr, r, lane); continue; } r -= I5;
        p0_transpose_item(P.in[I_WPG], DM, 0, DM, 32, P.in[I_PNG], (bf16_t*)(ws + WS_WPG), 0, scr, r, lane);
    }
}
__device__ __forceinline__ void phase_prologue(const Params& P, LAS unsigned char* lds, int tid, int lane, int wave) {
    unsigned char* ws = P.ws;
    LAS float* scr = (LAS float*)(lds + wave * 16384);
    const int gw = blockIdx.x * NWAVES + wave, NGW = gridDim.x * NWAVES;
    transposes_early(P, scr, gw, NGW, lane);
    if (gridDim.x != 256) transposes_late(P, scr, gw, NGW, lane);
    const float* x = P.in[I_X]; const float* g1 = P.in[I_N1G]; const float* pp = P.in[I_P];
    bf16_t* XN = (bf16_t*)(ws + WS_XN); bf16_t* PB = (bf16_t*)(ws + WS_PB);
    for (int m0 = gw; m0 < M; m0 += 4 * NGW) {
        f32x4 v[4][4]; f32x4 pv[4]; float s[4];
#pragma unroll
        for (int u = 0; u < 4; ++u) { const int m = m0 + u * NGW; const f32x4* xr = (const f32x4*)(x + (size_t)m * DM) + lane;
#pragma unroll
            for (int j = 0; j < 4; ++j) v[u][j] = __builtin_nontemporal_load(xr + 64 * j);
            pv[u] = __builtin_nontemporal_load((const f32x4*)(pp + (size_t)m * DPLE) + lane); }
#pragma unroll
        for (int u = 0; u < 4; ++u) { s[u] = 0.f;
#pragma unroll
            for (int j = 0; j < 4; ++j) s[u] += (v[u][j][0] * v[u][j][0] + v[u][j][1] * v[u][j][1]) + (v[u][j][2] * v[u][j][2] + v[u][j][3] * v[u][j][3]); }
#pragma unroll
        for (int u = 0; u < 4; ++u) { const int m = m0 + u * NGW; const float rstd = rsqrtf(wave_sum_all(s[u]) * (1.f / DM) + RMS_EPS);
            u32x2* o8 = (u32x2*)(XN + (size_t)m * DM) + lane;
#pragma unroll
            for (int j = 0; j < 4; ++j) { const f32x4 g = *((const f32x4*)g1 + lane + 64 * j); u32x2 w; w.x = cvt_pk_bf16(v[u][j][0] * rstd * g[0], v[u][j][1] * rstd * g[1]); w.y = cvt_pk_bf16(v[u][j][2] * rstd * g[2], v[u][j][3] * rstd * g[3]); o8[64 * j] = w; }
            u32x2 w; w.x = cvt_pk_bf16(pv[u][0], pv[u][1]); w.y = cvt_pk_bf16(pv[u][2], pv[u][3]);
            __builtin_nontemporal_store(w, (u32x2*)(PB + (size_t)m * DPLE) + lane); }
    }
    float* rs = (float*)(ws + WS_ROWSQ1);
    for (int i = blockIdx.x * NTHREADS + tid; i < 2 * M; i += gridDim.x * NTHREADS) rs[i] = 0.f;
}

__device__ __forceinline__ int tsw(int row, int s) { return row * 136 + ((((s >> 3) ^ (row >> 3)) & 15) << 3) + (s & 7); }

struct ConvW { float w[3][8]; float b[8]; };
__device__ __forceinline__ void load_convw(ConvW& c, const float* conv_w, const float* conv_b, int ch) {
#pragma unroll
    for (int t = 0; t < 3; ++t) { const f32x4 a = *(const f32x4*)(conv_w + t * 1024 + ch), b = *(const f32x4*)(conv_w + t * 1024 + ch + 4);
#pragma unroll
        for (int j = 0; j < 4; ++j) { c.w[t][j] = a[j]; c.w[t][4 + j] = b[j]; } }
    const f32x4 a = *(const f32x4*)(conv_b + ch), b = *(const f32x4*)(conv_b + ch + 4);
#pragma unroll
    for (int j = 0; j < 4; ++j) { c.b[j] = a[j]; c.b[4 + j] = b[j]; }
}
__device__ __forceinline__ void conv_silu8(const bf16_t* rowp, int p, const ConvW& c, float (&y)[8]) {
    const u32x4 z = {0u, 0u, 0u, 0u};
    const u32x4 x0 = *(const u32x4*)rowp;
    const u32x4 xm = (p > 0) ? *(const u32x4*)(rowp - PROJ_LD) : z;
    const u32x4 xp = (p < SEQ - 1) ? *(const u32x4*)(rowp + PROJ_LD) : z;
#pragma unroll
    for (int q = 0; q < 4; ++q) {
        float a = c.w[0][2 * q] * bflo(xm[q]) + c.w[1][2 * q] * bflo(x0[q]) + c.w[2][2 * q] * bflo(xp[q]) + c.b[2 * q];
        float b = c.w[0][2 * q + 1] * bfhi(xm[q]) + c.w[1][2 * q + 1] * bfhi(x0[q]) + c.w[2][2 * q + 1] * bfhi(xp[q]) + c.b[2 * q + 1];
        y[2 * q] = a * sigmoidf_(a); y[2 * q + 1] = b * sigmoidf_(b);
    }
}

struct Raw3 { u32x4 xm, x0, xp; };
template <bool NT> __device__ __forceinline__ u32x4 ld16(const bf16_t* p) { if constexpr (NT) return __builtin_nontemporal_load((const u32x4*)p); else return *(const u32x4*)p; }
template <bool NT = false> __device__ __forceinline__ Raw3 conv_load3(const bf16_t* rowp, int p) { Raw3 r; const u32x4 z = {0u, 0u, 0u, 0u};
    r.x0 = ld16<NT>(rowp); r.xm = (p > 0) ? ld16<NT>(rowp - PROJ_LD) : z; r.xp = (p < SEQ - 1) ? ld16<NT>(rowp + PROJ_LD) : z; return r; }
__device__ __forceinline__ void conv_apply8(const Raw3& r, const ConvW& c, float (&y)[8]) {
#pragma unroll
    for (int q = 0; q < 4; ++q) {
        float a = c.w[0][2 * q] * bflo(r.xm[q]) + c.w[1][2 * q] * bflo(r.x0[q]) + c.w[2][2 * q] * bflo(r.xp[q]) + c.b[2 * q];
        float b = c.w[0][2 * q + 1] * bfhi(r.xm[q]) + c.w[1][2 * q + 1] * bfhi(r.x0[q]) + c.w[2][2 * q + 1] * bfhi(r.xp[q]) + c.b[2 * q + 1];
        y[2 * q] = a * sigmoidf_(a); y[2 * q + 1] = b * sigmoidf_(b);
    }
}
constexpr int ML_A0 = 0, ML_A1 = 34816, ML_A2 = 69632, ML_ARR = 104448;

__device__ __forceinline__ void phase_mlstm_a(const Params& P, LAS unsigned char* lds, int tid0, int lane0, int wave) {
    unsigned char* ws = P.ws;
    const bf16_t* proj = (const bf16_t*)(ws + WS_PROJ); const float* gates = (const float*)(ws + WS_GATES);
    bf16_t* cloc = (bf16_t*)P.out; float* nloc = (float*)(ws + WS_NLOC); float* FC = (float*)(ws + WS_FC); float* MLOC = (float*)(ws + WS_MLOC);
    LAS bf16_t* VT = (LAS bf16_t*)(lds + ML_A0); LAS bf16_t* KW0 = (LAS bf16_t*)(lds + ML_A1); LAS bf16_t* KW1 = (LAS bf16_t*)(lds + ML_A2);
    LAS float* arr = (LAS float*)(lds + ML_ARR);
    for (int item = blockIdx.x; item < 512; item += gridDim.x) {
        int tid = tid0; asm volatile("" : "+v"(tid));
        const int lane = tid & 63, fr = lane & 15, fq = lane >> 4; (void)lane0;
        const int bh = item >> 6, T = item & 63, b = bh >> 2, h = bh & 3; const int tok0 = b * SEQ + T * 128;
        Raw3 rk[4]; u32x4 rv[4];
#pragma unroll
        for (int i = 0; i < 4; ++i) { const int s_ = (tid >> 4) + 32 * i; const bf16_t* rowp = proj + (size_t)(tok0 + s_) * PROJ_LD + h * 128 + 8 * (tid & 15);
            rk[i] = conv_load3(rowp + 512, T * 128 + s_); rv[i] = *(const u32x4*)(rowp + 1024); }
        if (tid < 128) { const float* g = gates + (size_t)(tok0 + tid) * 16 + h;
            arr[128 + tid] = g[0]; arr[tid] = g[4]; arr[384 + tid] = g[8]; arr[256 + tid] = g[12]; }
        __syncthreads();
        if (wave < 2) { const bool rev = wave == 1; const LAS float* lf = arr + (rev ? 256 : 0); const LAS float* ii = arr + (rev ? 384 : 128);
            const int p0 = 2 * lane, p1 = p0 + 1, i0 = rev ? 127 - p0 : p0, i1 = rev ? 127 - p1 : p1;
            const float x0 = lf[i0], x1 = lf[i1]; const float inc = wave_incl_sum(x0 + x1, lane); const float F = __shfl(inc, 63);
            const float a0 = ii[i0] + F - (inc - x1), a1 = ii[i1] + F - inc; const float ml = wave_max_all(fmaxf(a0, a1));
            arr[512 + wave * 128 + i0] = __expf(a0 - ml); arr[512 + wave * 128 + i1] = __expf(a1 - ml);
            if (lane == 0) { FC[(bh * 2 + wave) * 64 + T] = F; MLOC[(bh * 2 + wave) * 64 + T] = ml; } }
        __syncthreads();
        { const int dg = tid & 15, d0 = 8 * dg, srow = tid >> 4; ConvW cw; load_convw(cw, P.in[I_CONVW], P.in[I_CONVB], 512 + h * 128 + d0);
#pragma unroll
            for (int i = 0; i < 4; ++i) { const int s = srow + 32 * i; const bf16_t* rowp = proj + (size_t)(tok0 + s) * PROJ_LD;
                float y[8]; conv_apply8(rk[i], cw, y); (void)rowp;
                const u32x4 vv = rv[i];
                const float wf = arr[512 + s] * 0.08838834764831845f, wb = arr[640 + s] * 0.08838834764831845f;
#pragma unroll
                for (int j = 0; j < 8; ++j) { const int o = tsw(d0 + j, s); KW0[o] = f2bf(y[j] * wf); KW1[o] = f2bf(y[j] * wb);
                    VT[o] = (bf16_t)((j & 1) ? (vv[j >> 1] >> 16) : (vv[j >> 1] & 0xffffu)); } } }
        __syncthreads();
#pragma unroll
        for (int dir = 0; dir < 2; ++dir) { const LAS bf16_t* KW = dir ? KW1 : KW0;
            f32x4 acc[9];
#pragma unroll
            for (int t = 0; t < 9; ++t) acc[t] = (f32x4){0.f, 0.f, 0.f, 0.f};
#pragma unroll
            for (int kk = 0; kk < 4; ++kk) { const bf16x8 af = *(const LAS bf16x8*)(KW + tsw(16 * wave + fr, 32 * kk + 8 * fq));
#pragma unroll
                for (int t = 0; t < 8; ++t) { const bf16x8 bfr = *(const LAS bf16x8*)(VT + tsw(16 * t + fr, 32 * kk + 8 * fq)); acc[t] = __builtin_amdgcn_mfma_f32_16x16x32_bf16(af, bfr, acc[t], 0, 0, 0); }
                const short one = (fr == 0) ? (short)0x3F80 : (short)0; const bf16x8 ones = {one, one, one, one, one, one, one, one};
                acc[8] = __builtin_amdgcn_mfma_f32_16x16x32_bf16(af, ones, acc[8], 0, 0, 0); }
            const int st = bh * 2 + dir; bf16_t* cl = cloc + ((size_t)(st * 64 + T)) * 16384;
#pragma unroll
            for (int t = 0; t < 8; ++t) { u32x2 w; w.x = cvt_pk_bf16(acc[t][0], acc[t][1]); w.y = cvt_pk_bf16(acc[t][2], acc[t][3]); *(u32x2*)(cl + (16 * t + fr) * 128 + 16 * wave + 4 * fq) = w; }
            if (fr == 0) *(f32x4*)(nloc + (size_t)(st * 64 + T) * 128 + 16 * wave + 4 * fq) = acc[8]; }
        __syncthreads();
    }
}

__device__ __forceinline__ void phase_mlstm_b(const Params& P, int tid) {
    unsigned char* ws = P.ws;
    const bf16_t* cloc = (const bf16_t*)P.out; bf16_t* cstart = (bf16_t*)P.out + (size_t)16 * 1024 * 1024;
    const float* nloc = (const float*)(ws + WS_NLOC); float* nstart = (float*)(ws + WS_NSTART);
    const float* FC = (const float*)(ws + WS_FC); const float* MLOC = (const float*)(ws + WS_MLOC); float* MSTART = (float*)(ws + WS_MSTART);
    const int nth = gridDim.x * NTHREADS;
    for (int it = blockIdx.x * NTHREADS + tid; it < 65536 + 512; it += nth) {
        const bool is_main = it < 65536; const int st = is_main ? (it >> 12) : ((it - 65536) >> 5); const int e4 = is_main ? (it & 4095) * 4 : ((it - 65536) & 31) * 4; const int dir = st & 1; const int stu = is_main ? __builtin_amdgcn_readfirstlane(st) : st;
        float m = 0.f; f32x4 C = {0.f, 0.f, 0.f, 0.f};
        for (int c0 = 0; c0 < 64; c0 += 16) {
            f32x4 v[16]; float Fv[16], Mv[16];
#pragma unroll
            for (int k = 0; k < 16; ++k) { const int T = dir ? 63 - (c0 + k) : c0 + k;
                if (is_main) { const u32x2 w = __builtin_nontemporal_load((const u32x2*)(cloc + (size_t)(st * 64 + T) * 16384 + e4)); v[k] = (f32x4){bflo(w.x), bfhi(w.x), bflo(w.y), bfhi(w.y)}; }
                else v[k] = __builtin_nontemporal_load((const f32x4*)(nloc + (size_t)(st * 64 + T) * 128 + e4));
                Fv[k] = FC[stu * 64 + T]; Mv[k] = MLOC[stu * 64 + T]; }
#pragma unroll
            for (int k = 0; k < 16; ++k) { const int T = dir ? 63 - (c0 + k) : c0 + k;
                if (is_main) { u32x2 w; w.x = cvt_pk_bf16(C[0], C[1]); w.y = cvt_pk_bf16(C[2], C[3]); *(u32x2*)(cstart + (size_t)(st * 64 + T) * 16384 + e4) = w; }
                else { *(f32x4*)(nstart + (size_t)(st * 64 + T) * 128 + e4) = C; if (e4 == 0) MSTART[st * 64 + T] = m; }
                const float mn = fmaxf(m + Fv[k], Mv[k]); const float wp = __expf(m + Fv[k] - mn), wl = __expf(Mv[k] - mn);
                C = C * wp + v[k] * wl; m = mn; }
        }
    }
}

__device__ __forceinline__ void phase_mlstm_c(const Params& P, LAS unsigned char* lds, int tid0, int lane0, int wave) {
    unsigned char* ws = P.ws;
    const bf16_t* proj = (const bf16_t*)(ws + WS_PROJ); const float* gates = (const float*)(ws + WS_GATES);
    const bf16_t* cstart = (const bf16_t*)P.out + (size_t)16 * 1024 * 1024; const float* nstart = (const float*)(ws + WS_NSTART); const float* MSTART = (const float*)(ws + WS_MSTART);
    bf16_t* Y = (bf16_t*)(ws + WS_Y); const float* mng = P.in[I_MNG];
    LAS bf16_t* QS = (LAS bf16_t*)(lds + ML_A0); LAS bf16_t* KS = (LAS bf16_t*)(lds + ML_A1); LAS bf16_t* VT = (LAS bf16_t*)(lds + ML_A2);
    LAS float* arr = (LAS float*)(lds + ML_ARR);
    LAS bf16_t* CL0 = (LAS bf16_t*)(lds + ML_ARR + 6144);
    for (int item = blockIdx.x; item < 512; item += gridDim.x) {
        int tid = tid0; asm volatile("" : "+v"(tid));
        const int lane = tid & 63, fr = lane & 15, fq = lane >> 4; (void)lane0;
        const int bh = item >> 6, T = item & 63, b = bh >> 2, h = bh & 3; const int tok0 = b * SEQ + T * 128;
        Raw3 rq[4], rk[4]; u32x4 rv[4];
#pragma unroll
        for (int i = 0; i < 4; ++i) { const int s_ = (tid >> 4) + 32 * i; const bf16_t* rowp = proj + (size_t)(tok0 + s_) * PROJ_LD + h * 128 + 8 * (tid & 15);
            rq[i] = conv_load3<true>(rowp, T * 128 + s_); rk[i] = conv_load3<true>(rowp + 512, T * 128 + s_); rv[i] = ld16<true>(rowp + 1024); }
        if (tid < 128) { const float* g = gates + (size_t)(tok0 + tid) * 16 + h;
            arr[128 + tid] = g[0]; arr[tid] = g[4]; arr[384 + tid] = g[8]; arr[256 + tid] = g[12]; }
        u32x4 c0v[4], c1v[4];
#pragma unroll
        for (int i = 0; i < 4; ++i) { const int id = tid + 512 * i; c0v[i] = __builtin_nontemporal_load((const u32x4*)(cstart + (size_t)((bh * 2 + 0) * 64 + T) * 16384 + id * 8)); c1v[i] = __builtin_nontemporal_load((const u32x4*)(cstart + (size_t)((bh * 2 + 1) * 64 + T) * 16384 + id * 8)); }
        __syncthreads();
        if (wave < 2) { const bool rev = wave == 1; const LAS float* lf = arr + (rev ? 256 : 0); const LAS float* ii = arr + (rev ? 384 : 128); LAS float* o = arr + 512 + wave * 512;
            const float ms = MSTART[(bh * 2 + wave) * 64 + T];
            const int p0 = 2 * lane, p1 = p0 + 1, i0 = rev ? 127 - p0 : p0, i1 = rev ? 127 - p1 : p1;
            const float x0 = lf[i0], x1 = lf[i1]; const float inc = wave_incl_sum(x0 + x1, lane); const float cb0 = inc - x1, cb1 = inc;
            const float u0 = ii[i0] - cb0, u1 = ii[i1] - cb1; const float incm = wave_incl_max(fmaxf(u0, u1), lane);
            float exm = __shfl_up(incm, 1); if (lane == 0) exm = -INFINITY;
            const float n0 = fmaxf(ms, fmaxf(exm, u0)), n1 = fmaxf(ms, incm);
            o[i0] = u0 * 1.4426950408889634f; o[i1] = u1 * 1.4426950408889634f; o[128 + i0] = n0 * 1.4426950408889634f; o[128 + i1] = n1 * 1.4426950408889634f;     o[256 + i0] = __expf(ms - n0); o[256 + i1] = __expf(ms - n1);
            o[384 + i0] = __expf(-(cb0 + n0)); o[384 + i1] = __expf(-(cb1 + n1)); }
        { const int dg = tid & 15, d0 = 8 * dg, srow = tid >> 4; ConvW cq, ck; load_convw(cq, P.in[I_CONVW], P.in[I_CONVB], h * 128 + d0); load_convw(ck, P.in[I_CONVW], P.in[I_CONVB], 512 + h * 128 + d0);
#pragma unroll
            for (int i = 0; i < 4; ++i) { const int s = srow + 32 * i; const bf16_t* rowp = proj + (size_t)(tok0 + s) * PROJ_LD;
                float yq[8], yk[8]; conv_apply8(rq[i], cq, yq); conv_apply8(rk[i], ck, yk); (void)rowp;
                const u32x4 vv = rv[i];
                u32x4 wq, wk; const float ksc = 0.08838834764831845f;
                wq.x = cvt_pk_bf16(yq[0], yq[1]); wq.y = cvt_pk_bf16(yq[2], yq[3]); wq.z = cvt_pk_bf16(yq[4], yq[5]); wq.w = cvt_pk_bf16(yq[6], yq[7]);
                wk.x = cvt_pk_bf16(yk[0] * ksc, yk[1] * ksc); wk.y = cvt_pk_bf16(yk[2] * ksc, yk[3] * ksc); wk.z = cvt_pk_bf16(yk[4] * ksc, yk[5] * ksc); wk.w = cvt_pk_bf16(yk[6] * ksc, yk[7] * ksc);
                *(LAS u32x4*)(QS + s * 136 + d0) = wq; *(LAS u32x4*)(KS + s * 136 + d0) = wk;
#pragma unroll
                for (int j = 0; j < 8; ++j) VT[tsw(d0 + j, s)] = (bf16_t)((j & 1) ? (vv[j >> 1] >> 16) : (vv[j >> 1] & 0xffffu)); } }
#pragma unroll
        for (int i = 0; i < 4; ++i) { const int id = tid + 512 * i; *(LAS u32x4*)(CL0 + (id >> 4) * 136 + (id & 15) * 8) = c0v[i]; }
        __syncthreads();
        bf16x8 qf[4];
#pragma unroll
        for (int kk = 0; kk < 4; ++kk) qf[kk] = *(const LAS bf16x8*)(QS + (16 * wave + fr) * 136 + 32 * kk + 8 * fq);
        __syncthreads();
#pragma unroll
        for (int i = 0; i < 4; ++i) { const int id = tid + 512 * i; *(LAS u32x4*)(QS + (id >> 4) * 136 + (id & 15) * 8) = c1v[i]; }
        u32x2 owv[8];
#pragma unroll
        for (int t = 0; t < 8; ++t) owv[t] = __builtin_nontemporal_load((const u32x2*)(proj + (size_t)(tok0 + 16 * wave + fr) * PROJ_LD + 1536 + h * 128 + 16 * t + 4 * fq));
        f32x4 sraw[8];
#pragma unroll
        for (int t = 0; t < 8; ++t) { f32x4 sa = {0.f, 0.f, 0.f, 0.f};
#pragma unroll
            for (int kk = 0; kk < 4; ++kk) { const bf16x8 kf = *(const LAS bf16x8*)(KS + (16 * t + fr) * 136 + 32 * kk + 8 * fq); sa = __builtin_amdgcn_mfma_f32_16x16x32_bf16(kf, qf[kk], sa, 0, 0, 0); }
            sraw[t] = sa; if (t & 1) __builtin_amdgcn_sched_barrier(0); }
        f32x4 hsum[8];
        const int l = 16 * wave + fr;
        {
#pragma unroll
        for (int t = 0; t < 8; ++t) hsum[t] = (f32x4){0.f, 0.f, 0.f, 0.f};
#pragma unroll 1
        for (int dir = 0; dir < 2; ++dir) {
            int lane_ = lane; asm volatile("" : "+v"(lane_));
            const int fr_ = lane_ & 15, fq_ = lane_ >> 4, l_ = 16 * wave + fr_;
            if (dir == 1) __syncthreads();
            const LAS bf16_t* CL = dir ? QS : CL0;
            const LAS float* o = arr + 512 + dir * 512; const float nl = o[128 + l_], wi = o[256 + l_], ei = o[384 + l_];
            const int st = bh * 2 + dir;
            unsigned pk[8][2];
#pragma unroll
            for (int t = 0; t < 8; ++t) {
                const bool t_all = dir ? (t > wave) : (t < wave); const bool t_diag = (t == wave);
                f32x4 sa = sraw[t];
                const f32x4 us = *(const LAS f32x4*)(o + 16 * t + 4 * fq_);
#pragma unroll
                for (int i = 0; i < 4; ++i) { const int dq = 4 * fq_ + i - fr_; const bool ok = t_all || (t_diag && (dir ? (dq >= 0) : (dq <= 0))); sa[i] = ok ? sa[i] * __builtin_amdgcn_exp2f(fminf(us[i] - nl, 0.f)) : 0.f; }
                pk[t][0] = cvt_pk_bf16(sa[0], sa[1]); pk[t][1] = cvt_pk_bf16(sa[2], sa[3]);
                if (t & 1) __builtin_amdgcn_sched_barrier(0); }
            f32x4 na[9];
#pragma unroll
            for (int t = 0; t < 9; ++t) na[t] = (f32x4){0.f, 0.f, 0.f, 0.f};
            const float* ns = nstart + (size_t)(st * 64 + T) * 128;
#pragma unroll
            for (int kk = 0; kk < 4; ++kk) {
#pragma unroll
                for (int t = 0; t < 8; ++t) { const bf16x8 cf = *(const LAS bf16x8*)(CL + (16 * t + fr_) * 136 + 32 * kk + 8 * fq_); na[t] = __builtin_amdgcn_mfma_f32_16x16x32_bf16(cf, qf[kk], na[t], 0, 0, 0); }
                u32x4 nw = {0u, 0u, 0u, 0u};
                if (fr_ == 0) { const f32x4 a = *(const f32x4*)(ns + 32 * kk + 8 * fq_), bb = *(const f32x4*)(ns + 32 * kk + 8 * fq_ + 4);
                    nw.x = cvt_pk_bf16(a[0], a[1]); nw.y = cvt_pk_bf16(a[2], a[3]); nw.z = cvt_pk_bf16(bb[0], bb[1]); nw.w = cvt_pk_bf16(bb[2], bb[3]); }
                na[8] = __builtin_amdgcn_mfma_f32_16x16x32_bf16(__builtin_bit_cast(bf16x8, nw), qf[kk], na[8], 0, 0, 0);
                __builtin_amdgcn_sched_barrier(0); }
#pragma unroll
            for (int t = 0; t < 9; ++t) na[t] = na[t] * wi;
#pragma unroll
            for (int kk = 0; kk < 4; ++kk) {
                u32x4 pw; pw.x = pk[2 * kk][0]; pw.y = pk[2 * kk][1]; pw.z = pk[2 * kk + 1][0]; pw.w = pk[2 * kk + 1][1]; const bf16x8 pf = __builtin_bit_cast(bf16x8, pw);
#pragma unroll
                for (int t = 0; t < 8; ++t) { const u32x2 a0 = *(const LAS u32x2*)(VT + tsw(16 * t + fr_, 32 * kk + 4 * fq_)), a1 = *(const LAS u32x2*)(VT + tsw(16 * t + fr_, 32 * kk + 16 + 4 * fq_));
                    u32x4 aw; aw.x = a0.x; aw.y = a0.y; aw.z = a1.x; aw.w = a1.y; na[t] = __builtin_amdgcn_mfma_f32_16x16x32_bf16(__builtin_bit_cast(bf16x8, aw), pf, na[t], 0, 0, 0); }
                const short one = (fr_ == 0) ? (short)0x3F80 : (short)0; const bf16x8 ones = {one, one, one, one, one, one, one, one};
                na[8] = __builtin_amdgcn_mfma_f32_16x16x32_bf16(ones, pf, na[8], 0, 0, 0);
                __builtin_amdgcn_sched_barrier(0); }
            const float den = __shfl(na[8][0], fr_); const float inv = __builtin_amdgcn_rcpf(fmaxf(fabsf(den), ei));
#pragma unroll
            for (int t = 0; t < 8; ++t) hsum[t] = hsum[t] + na[t] * inv;
        }
        }
        float ss = 0.f;
#pragma unroll
        for (int t = 0; t < 8; ++t) ss += (hsum[t][0] * hsum[t][0] + hsum[t][1] * hsum[t][1]) + (hsum[t][2] * hsum[t][2] + hsum[t][3] * hsum[t][3]);
        ss += __shfl_xor(ss, 16); ss += __shfl_xor(ss, 32);
        const float rstd = rsqrtf(ss * (1.0f / 128.0f) + RMS_EPS);
        const size_t tok = (size_t)(tok0 + l);
#pragma unroll
        for (int t = 0; t < 8; ++t) { const int e = 16 * t + 4 * fq; const f32x4 g = *(const f32x4*)(mng + h * 128 + e); const u32x2 ow = owv[t];
            const float y0 = hsum[t][0] * rstd * g[0] * sigmoidf_(bflo(ow.x)), y1 = hsum[t][1] * rstd * g[1] * sigmoidf_(bfhi(ow.x)),
                        y2 = hsum[t][2] * rstd * g[2] * sigmoidf_(bflo(ow.y)), y3 = hsum[t][3] * rstd * g[3] * sigmoidf_(bfhi(ow.y));
            u32x2 w; w.x = cvt_pk_bf16(y0, y1); w.y = cvt_pk_bf16(y2, y3); *(u32x2*)(Y + tok * DM + h * 128 + e) = w; }
        __syncthreads();
    }
}

constexpr int NA_K = 0, NA_V = 73728, NA_TAB = 140288, NA_EX = 142208;
struct NaRow { u32x4 k, v; };
__device__ __forceinline__ NaRow na_load(const bf16_t* proj, const bf16_t* vtn, int b, int h, int g, int tid) {
    const int col = tid >> 3, ch = tid & 7; NaRow x;
    x.k = *(const u32x4*)(proj + ((size_t)(b * SEQ + g * 64 + col)) * PROJ_LD + 2560 + h * 64 + 8 * ch);
    x.v = *(const u32x4*)(vtn + ((size_t)((b * 8 + h) * 64 + col)) * SEQ + g * 64 + 8 * ch);
    return x;
}
__device__ __forceinline__ void na_store(const NaRow& x, int slot, LAS unsigned char* lds, int tid) {
    const int col = tid >> 3, ch = tid & 7; float v[8]; float ss = 0.f;
#pragma unroll
    for (int q = 0; q < 4; ++q) { v[2 * q] = bflo(x.k[q]); v[2 * q + 1] = bfhi(x.k[q]); ss += v[2 * q] * v[2 * q] + v[2 * q + 1] * v[2 * q + 1]; }
    ss += __shfl_xor(ss, 1); ss += __shfl_xor(ss, 2); ss += __shfl_xor(ss, 4);
    const float rk = rsqrtf(ss * (1.0f / 64.0f) + RMS_EPS); u32x4 w;
    w.x = cvt_pk_bf16(v[0] * rk, v[1] * rk); w.y = cvt_pk_bf16(v[2] * rk, v[3] * rk); w.z = cvt_pk_bf16(v[4] * rk, v[5] * rk); w.w = cvt_pk_bf16(v[6] * rk, v[7] * rk);
    *(LAS u32x4*)(lds + NA_K + ((slot * 64 + col) * 72 + 8 * ch) * 2) = w;
    *(LAS u32x4*)(lds + NA_V + (col * 520 + slot * 64 + 8 * ch) * 2) = x.v;
}
__device__ __forceinline__ void phase_natten2(const Params& P, LAS unsigned char* lds, int tid0, int wave) {
    unsigned char* ws = P.ws;
    const bf16_t* proj = (const bf16_t*)(ws + WS_PROJ); const bf16_t* vtn = (const bf16_t*)(ws + WS_VTN); bf16_t* Y = (bf16_t*)(ws + WS_Y);
    const float* qg = P.in[I_QNG]; const float* kg = P.in[I_KNG]; const float* rpb = P.in[I_RPB];
    LAS float* tab = (LAS float*)(lds + NA_TAB); LAS float* ex = (LAS float*)(lds + NA_EX);
    const LAS bf16_t* KL = (const LAS bf16_t*)(lds + NA_K); const LAS bf16_t* VL = (const LAS bf16_t*)(lds + NA_V);
    for (int run = blockIdx.x; run < 256; run += gridDim.x) {
        int tid = tid0; asm volatile("" : "+v"(tid));
        const int lane = tid & 63, fr = lane & 15, fq = lane >> 4;
        const int bh = run >> 4, b = bh >> 3, h = bh & 7, r0 = (run & 15) * 8;
        const int j = wave & 3, half = wave >> 2;
        if (tid < 480) { const int ro = tid >> 5, co = tid & 31; tab[tid] = (co < 31) ? rpb[(h * 15 + ro) * 31 + co] * 1.4426950408889634f : -INFINITY; }
        const int c0 = min(max(16 * j - 8, 0), 32), c = 16 * j + fr, cs = min(max(c - 8, 0), 48);
        int coidx[2][4];
#pragma unroll
        for (int hh = 0; hh < 2; ++hh)
#pragma unroll
            for (int i = 0; i < 4; ++i) { const int cc = c0 + 16 * hh + 4 * fq + i; const bool ok = (cc >= cs) && (cc < cs + 16); coidx[hh][i] = ok ? (cc - c + 15) : 31; }
        float gqk[16];
#pragma unroll
        for (int kk = 0; kk < 2; ++kk) { const int d = h * 64 + 32 * kk + 8 * fq;
            const f32x4 ga = *(const f32x4*)(qg + d), gb = *(const f32x4*)(qg + d + 4), ka = *(const f32x4*)(kg + d), kb = *(const f32x4*)(kg + d + 4);
#pragma unroll
            for (int q = 0; q < 4; ++q) { gqk[8 * kk + q] = ga[q] * ka[q] * (0.125f * 1.4426950408889634f); gqk[8 * kk + 4 + q] = gb[q] * kb[q] * (0.125f * 1.4426950408889634f); } }
        int rs = min(max(r0 - 4, 0), 120);
#pragma unroll
        for (int gg = 0; gg < 8; ++gg) { const NaRow x = na_load(proj, vtn, b, h, rs + gg, tid); na_store(x, (rs + gg) & 7, lds, tid); }
        int hi = rs + 7;
        u32x4 qw[2];
#pragma unroll
        for (int kk = 0; kk < 2; ++kk) qw[kk] = ld16<true>(proj + ((size_t)b * SEQ + r0 * 64 + c) * PROJ_LD + 2048 + h * 64 + 32 * kk + 8 * fq);
#pragma unroll 1
        for (int r = r0; r < r0 + 8; ++r) {
            rs = min(max(r - 4, 0), 120);
            __syncthreads();
            const int rsn = min(max(r - 3, 0), 120); const bool pre = (r + 1 < r0 + 8) && (rsn + 7 > hi);
            NaRow nx; nx.k = (u32x4){0u, 0u, 0u, 0u}; nx.v = nx.k; if (pre) nx = na_load(proj, vtn, b, h, rsn + 7, tid);
            const size_t tokq = (size_t)b * SEQ + r * 64 + c;
            bf16x8 qf[2];
            { u32x4 w[2]; float v[16]; float ss = 0.f;
#pragma unroll
                for (int kk = 0; kk < 2; ++kk) { w[kk] = qw[kk];
#pragma unroll
                    for (int q = 0; q < 4; ++q) { v[8 * kk + 2 * q] = bflo(w[kk][q]); v[8 * kk + 2 * q + 1] = bfhi(w[kk][q]); } }
#pragma unroll
                for (int q = 0; q < 16; ++q) ss += v[q] * v[q];
                ss += __shfl_xor(ss, 16); ss += __shfl_xor(ss, 32);
                const float rq = rsqrtf(ss * (1.0f / 64.0f) + RMS_EPS);
#pragma unroll
                for (int kk = 0; kk < 2; ++kk) { u32x4 o;
                    o.x = cvt_pk_bf16(v[8 * kk + 0] * rq * gqk[8 * kk + 0], v[8 * kk + 1] * rq * gqk[8 * kk + 1]); o.y = cvt_pk_bf16(v[8 * kk + 2] * rq * gqk[8 * kk + 2], v[8 * kk + 3] * rq * gqk[8 * kk + 3]);
                    o.z = cvt_pk_bf16(v[8 * kk + 4] * rq * gqk[8 * kk + 4], v[8 * kk + 5] * rq * gqk[8 * kk + 5]); o.w = cvt_pk_bf16(v[8 * kk + 6] * rq * gqk[8 * kk + 6], v[8 * kk + 7] * rq * gqk[8 * kk + 7]);
                    qf[kk] = __builtin_bit_cast(bf16x8, o); } }
            { const int rn = (r + 1 < r0 + 8) ? r + 1 : r;
#pragma unroll
              for (int kk = 0; kk < 2; ++kk) qw[kk] = ld16<true>(proj + ((size_t)b * SEQ + rn * 64 + c) * PROJ_LD + 2048 + h * 64 + 32 * kk + 8 * fq); }
            float mx, sum; f32x4 oa[4];
            {
            f32x4 sc[8]; mx = -INFINITY;
#pragma unroll
            for (int kr = 0; kr < 4; ++kr) { const int g = rs + 4 * half + kr, slot = g & 7, ro = g - r + 7;
#pragma unroll
                for (int hh = 0; hh < 2; ++hh) { const int t = 2 * kr + hh; const LAS bf16_t* kp = KL + (slot * 64 + c0 + 16 * hh + fr) * 72 + 8 * fq;
                    const bf16x8 k0 = *(const LAS bf16x8*)kp, k1 = *(const LAS bf16x8*)(kp + 32);
                    f32x4 sa = {0.f, 0.f, 0.f, 0.f};
                    sa = __builtin_amdgcn_mfma_f32_16x16x32_bf16(k0, qf[0], sa, 0, 0, 0);
                    sa = __builtin_amdgcn_mfma_f32_16x16x32_bf16(k1, qf[1], sa, 0, 0, 0);
#pragma unroll
                    for (int i = 0; i < 4; ++i) { const float v = sa[i] + tab[ro * 32 + coidx[hh][i]]; sc[t][i] = v; mx = fmaxf(mx, v); } } }
            mx = fmaxf(mx, __shfl_xor(mx, 16)); mx = fmaxf(mx, __shfl_xor(mx, 32));
            sum = 0.f; unsigned pk[8][2];
#pragma unroll
            for (int t = 0; t < 8; ++t) { f32x4 e;
#pragma unroll
                for (int i = 0; i < 4; ++i) { e[i] = __builtin_amdgcn_exp2f(sc[t][i] - mx); sum += e[i]; }
                pk[t][0] = cvt_pk_bf16(e[0], e[1]); pk[t][1] = cvt_pk_bf16(e[2], e[3]); }
            sum += __shfl_xor(sum, 16); sum += __shfl_xor(sum, 32);
#pragma unroll
            for (int nt = 0; nt < 4; ++nt) oa[nt] = (f32x4){0.f, 0.f, 0.f, 0.f};
#pragma unroll
            for (int kr = 0; kr < 4; ++kr) { const int slot = (rs + 4 * half + kr) & 7;
                u32x4 pw; pw.x = pk[2 * kr][0]; pw.y = pk[2 * kr][1]; pw.z = pk[2 * kr + 1][0]; pw.w = pk[2 * kr + 1][1]; const bf16x8 pf = __builtin_bit_cast(bf16x8, pw);
#pragma unroll
                for (int nt = 0; nt < 4; ++nt) { const LAS bf16_t* vp = VL + (16 * nt + fr) * 520 + slot * 64 + c0 + 4 * fq;
                    const u32x2 a0 = *(const LAS u32x2*)vp, a1 = *(const LAS u32x2*)(vp + 16); u32x4 aw; aw.x = a0.x; aw.y = a0.y; aw.z = a1.x; aw.w = a1.y;
                    oa[nt] = __builtin_amdgcn_mfma_f32_16x16x32_bf16(__builtin_bit_cast(bf16x8, aw), pf, oa[nt], 0, 0, 0); } }
            }
            if (half == 1) {
#pragma unroll
                for (int nt = 0; nt < 4; ++nt)
#pragma unroll
                    for (int i = 0; i < 4; ++i) ex[((4 * nt + i) * 4 + j) * 64 + lane] = oa[nt][i];
                ex[(16 * 4 + j) * 64 + lane] = mx; ex[(17 * 4 + j) * 64 + lane] = sum; }
            __syncthreads();
            if (pre) { na_store(nx, (rsn + 7) & 7, lds, tid); hi = rsn + 7; }
            if (half == 0) {
                const float m1 = ex[(16 * 4 + j) * 64 + lane], s1 = ex[(17 * 4 + j) * 64 + lane];
                const float m = fmaxf(mx, m1), f0 = __builtin_amdgcn_exp2f(mx - m), f1 = __builtin_amdgcn_exp2f(m1 - m); const float inv = __builtin_amdgcn_rcpf(sum * f0 + s1 * f1); const float g0 = f0 * inv, g1 = f1 * inv;
#pragma unroll
                for (int nt = 0; nt < 4; ++nt) { float o[4];
#pragma unroll
                    for (int i = 0; i < 4; ++i) o[i] = oa[nt][i] * g0 + ex[((4 * nt + i) * 4 + j) * 64 + lane] * g1;
                    u32x2 w; w.x = cvt_pk_bf16(o[0], o[1]); w.y = cvt_pk_bf16(o[2], o[3]);
                    *(u32x2*)(Y + tokq * DM + 512 + h * 64 + 16 * nt + 4 * fq) = w; } }
        }
        __syncthreads();
    }
}

#define GAS __attribute__((address_space(1)))
#define RLX_AGENT __ATOMIC_RELAXED, __HIP_MEMORY_SCOPE_AGENT
#define XB_TMO      128
#define XB_XCNT(j)  (256  + 64 * (j))
#define XB_XSUB(j)  (1280 + 64 * (j))
#define XB_XGEN(j)  (2304 + 64 * (j))
#define XB_TOP      3328
#define XB_TOPGEN   3392
#define XCD_BAR_WORDS 3456
#define XB_SPIN_CAP (1u << 18)

__device__ __forceinline__ unsigned xb_ld(unsigned* p)              { return __hip_atomic_load(p, __ATOMIC_RELAXED, __HIP_MEMORY_SCOPE_AGENT); }
__device__ __forceinline__ unsigned xb_add(unsigned* p, unsigned v) { return __hip_atomic_fetch_add(p, v, __ATOMIC_RELAXED, __HIP_MEMORY_SCOPE_AGENT); }
__device__ __forceinline__ unsigned xb_xcc_id() { return (unsigned)__builtin_amdgcn_s_getreg((3 << 11) | 20) & 0xFu; }
#define XB_SPIN(cond, bar) do { unsigned _sp = 0; while (cond) { __builtin_amdgcn_s_sleep(1); \
    if ((++_sp & 255u) == 0u) { if (xb_ld(&(bar)[XB_TMO])) break; if (_sp > XB_SPIN_CAP) { atomicAdd(&(bar)[XB_TMO], 1u); break; } } } } while (0)

struct XcdBarrier {
    unsigned* bar; unsigned x;
    volatile LAS unsigned* st;
};

__device__ __forceinline__ XcdBarrier xcd_barrier_post(unsigned* bar, volatile LAS unsigned* st) {
    XcdBarrier b; b.bar = bar; b.x = xb_xcc_id(); b.st = st;
    if (threadIdx.x == 0) (void)xb_add(&bar[XB_XCNT(b.x)], 1u);
    return b;
}
__device__ __forceinline__ void xcd_barrier_complete(unsigned* bar, unsigned x, unsigned& nloc, unsigned& nx) {
    const unsigned G = gridDim.x * gridDim.y * gridDim.z;
    unsigned sum, cnt, mine, sp = 0u;
    for (;;) {
        sum = 0u; cnt = 0u; mine = 0u;
#pragma unroll
        for (unsigned j = 0; j < 16; ++j) { const unsigned c = xb_ld(&bar[XB_XCNT(j)]); sum += c; cnt += (c > 0u) ? 1u : 0u; mine = (j == x) ? c : mine; }
        if (sum == G) break;
        __builtin_amdgcn_s_sleep(1);
        if ((++sp & 255u) == 0u) { if (xb_ld(&bar[XB_TMO])) break; if (sp > XB_SPIN_CAP) { atomicAdd(&bar[XB_TMO], 1u); break; } }
    }
    nloc = mine > 0u ? mine : 1u; nx = cnt > 0u ? cnt : 1u;
}

__device__ __forceinline__ void xcd_barrier(const XcdBarrier& b) {
    asm volatile("s_waitcnt vmcnt(0)" ::: "memory");
    __syncthreads();
    if (threadIdx.x == 0) {
        unsigned* bar = b.bar;
        __builtin_amdgcn_s_waitcnt(0);
        unsigned nloc = b.st[0], nx = b.st[1];
        if (nloc == 0u) { xcd_barrier_complete(bar, b.x, nloc, nx); b.st[0] = nloc; b.st[1] = nx; }
        const unsigned old = xb_add(&bar[XB_XSUB(b.x)], 1u);
        const unsigned gen = old / nloc;
        if (old + 1u == (gen + 1u) * nloc) {
            __builtin_amdgcn_fence(__ATOMIC_RELEASE, "agent");
            asm volatile("s_waitcnt vmcnt(0)" ::: "memory");
            const unsigned og = xb_add(&bar[XB_TOP], 1u);
            const unsigned tg = og / nx;
            if (og + 1u == (tg + 1u) * nx) xb_add(&bar[XB_TOPGEN], 1u);
            else XB_SPIN(xb_ld(&bar[XB_TOPGEN]) == tg, bar);
            __builtin_amdgcn_fence(__ATOMIC_ACQUIRE, "agent");
            xb_add(&bar[XB_XGEN(b.x)], 1u);
            asm volatile("s_waitcnt vmcnt(0)" ::: "memory");
        } else {
            XB_SPIN(xb_ld(&bar[XB_XGEN(b.x)]) == gen, bar);
            __builtin_amdgcn_fence(__ATOMIC_ACQUIRE, "agent");
            asm volatile("s_waitcnt vmcnt(0)" ::: "memory");
        }
    }
    __syncthreads();
}
#ifndef N_LAUNCH_SPLIT
#define N_LAUNCH_SPLIT 0
#endif
__device__ __forceinline__ void run_phase(const Params& P, LAS unsigned char* lds, int ph, int tid, int lane, int wave) {
    unsigned char* ws = P.ws;
    const int G = gridDim.x, c = blockIdx.x;
    if (ph == 0) phase_prologue(P, lds, tid, lane, wave);
    else if (ph == 1) {
        { pg8::Gemm g{(const bf16_t*)(ws + WS_XN), (const bf16_t*)(ws + WS_WIN), M, NPROJ, DM}; pg8::StaticOrder S; S.init(M, NPROJ, G, c);
          EpiInProj E{(bf16_t*)(ws + WS_PROJ), (bf16_t*)(ws + WS_VTN), (float*)(ws + WS_GATES), P.in[I_GATEB]};
          pg8::gemm_phase<EpiInProj, pg8::StaticOrder, true, true>(lds, g, S, E, tid); }
        if (G == 256 && c >= 192) { __syncthreads(); transposes_late(P, (LAS float*)(lds + wave * 16384), (c - 192) * NWAVES + wave, 64 * NWAVES, lane); }
    } else if (ph == 2) { phase_mlstm_a(P, lds, tid, lane, wave); phase_natten2(P, lds, tid, wave); }
    else if (ph == 20) phase_natten2(P, lds, tid, wave);
    else if (ph == 21) phase_mlstm_a(P, lds, tid, lane, wave);
    else if (ph == 3) { phase_mlstm_b(P, tid);
        { int kple = DPLE; asm volatile("" : "+s"(kple));
          pg8::Gemm g{(const bf16_t*)(ws + WS_PB), (const bf16_t*)(ws + WS_WPU), M, DM, kple};
          EpiBf16Plain E{(bf16_t*)(ws + WS_PU), DM};
          if (G == 256) { PuOrder S{c}; pg8::gemm_phase<EpiBf16Plain, PuOrder, true, true>(lds, g, S, E, tid); }
          else { pg8::StaticOrder S; S.init(M, DM, G, c); pg8::gemm_phase<EpiBf16Plain, pg8::StaticOrder, true, true>(lds, g, S, E, tid); } }
    }
    else if (ph == 4) phase_mlstm_c(P, lds, tid, lane, wave);
    else if (ph == 5) { pg8::Gemm g{(const bf16_t*)(ws + WS_Y), (const bf16_t*)(ws + WS_WOUT), M, DM, DM}; pg8::StaticOrder S; S.init(M, DM, G, c);
        EpiResid E{P.in[I_X], nullptr, (bf16_t*)(ws + WS_XN), (float*)(ws + WS_ROWSQ1)};
        pg8::gemm_phase<EpiResid, pg8::StaticOrder, true, true>(lds, g, S, E, tid); }
    else if (ph == 50) { pg8::Gemm g{(const bf16_t*)(ws + WS_Y), (const bf16_t*)(ws + WS_WOUT), M, DM, DM}; pg8::StaticOrder S; S.init(M, DM, G, c);
        EpiResid E{P.in[I_X], nullptr, (bf16_t*)(ws + WS_XN), (float*)(ws + WS_NLOC)};
        pg8::gemm_phase<EpiResid, pg8::StaticOrder, true, true>(lds, g, S, E, tid); }
    else if (ph == 6) { pg8::Gemm g{(const bf16_t*)(ws + WS_XN), (const bf16_t*)(ws + WS_WFF1), M, DFF, DM}; pg8::StaticOrder S; S.init(M, DFF, G, c);
        EpiRelu2 E{(bf16_t*)(ws + WS_HID), (const float*)(ws + WS_ROWSQ1)};
        pg8::gemm_phase<EpiRelu2, pg8::StaticOrder, true, true>(lds, g, S, E, tid); }
    else if (ph == 7) { pg8::Gemm g{(const bf16_t*)(ws + WS_HID), (const bf16_t*)(ws + WS_WFF2), M, DM, DFF}; pg8::StaticOrder S; S.init(M, DM, G, c);
        EpiResid E{nullptr, (const bf16_t*)(ws + WS_XN), (bf16_t*)(ws + WS_XN), (float*)(ws + WS_ROWSQ2)};
        pg8::gemm_phase<EpiResid, pg8::StaticOrder, true, true>(lds, g, S, E, tid); }
    else if (ph == 8) { pg8::Gemm g{(const bf16_t*)(ws + WS_XN), (const bf16_t*)(ws + WS_WPG), M, DM, DM}; pg8::StaticOrder S; S.init(M, DM, G, c);
        EpiPle E{(const bf16_t*)(ws + WS_XN), P.out, (const bf16_t*)(ws + WS_PU), (const float*)(ws + WS_ROWSQ2)};
        pg8::gemm_phase<EpiPle, pg8::StaticOrder, true, true>(lds, g, S, E, tid); }
}
constexpr int NPHASE = 9;

__global__ void __launch_bounds__(NTHREADS, 2) fwd_mega(Params P) {
    extern __shared__ __attribute__((aligned(16))) unsigned char lds_raw[];
    LAS unsigned char* lds = (LAS unsigned char*)lds_raw;
    cg::grid_group grid = cg::this_grid();
    const int tid = threadIdx.x, lane = tid & 63, wave = __builtin_amdgcn_readfirstlane(tid >> 6); const int wave_s = wave; (void)lane;
    volatile LAS unsigned* bst = (volatile LAS unsigned*)(lds + 163840 - 64);
    if (tid < 2) bst[tid] = 0u;
    __syncthreads();
    XcdBarrier xbar = xcd_barrier_post((unsigned*)(P.ws + WS_BAR), bst);
    if (P.ws == nullptr) grid.sync();
#define GSYNC() xcd_barrier(xbar)
#if defined(__HIP_DEVICE_COMPILE__)
#define RUNP(k) do { const __attribute__((address_space(4))) Params* pp = (const __attribute__((address_space(4))) Params*)__builtin_amdgcn_kernarg_segment_ptr(); \
        asm volatile("" : "+s"(pp)); Params Pl; __builtin_memcpy(&Pl, (const Params*)pp, sizeof(Params)); int t_ = threadIdx.x; asm volatile("" : "+v"(t_)); \
        run_phase(Pl, lds, (k), t_, t_ & 63, __builtin_amdgcn_readfirstlane(t_ >> 6)); } while (0)
#else
#define RUNP(k) run_phase(P, lds, (k), tid, lane, wave)
#endif
#ifndef DBG_STOP
#ifdef DBL_PHASE
#define DBL(k) do { if (DBL_PHASE == (k)) { RUNP(k); GSYNC(); } } while (0)
#else
#define DBL(k) do { } while (0)
#endif
#ifdef EXTRA_SYNCS
    for (int es = 0; es < EXTRA_SYNCS; ++es) GSYNC();
#endif
    DBL(0); RUNP(0); GSYNC(); DBL(1); RUNP(1); GSYNC(); DBL(20); DBL(21); DBL(2); RUNP(2); GSYNC(); DBL(3); RUNP(3); GSYNC(); DBL(4); RUNP(4); GSYNC(); DBL(50); RUNP(5); GSYNC(); DBL(6); RUNP(6); GSYNC(); RUNP(7); GSYNC(); RUNP(8);
#else
    RUNP(0); GSYNC();
    if (DBG_STOP >= 1) { RUNP(1); GSYNC(); }
    if (DBG_STOP >= 2) { RUNP(2); GSYNC(); }
    if (DBG_STOP >= 3) { RUNP(3); GSYNC(); }
    if (DBG_STOP >= 4) { RUNP(4); GSYNC(); }
    if (DBG_STOP >= 5) { RUNP(5); GSYNC(); }
    if (DBG_STOP >= 6) { RUNP(6); GSYNC(); }
    if (DBG_STOP >= 7) { RUNP(7); GSYNC(); }
#ifdef DBG_PRE_OFF
    { const bf16_t* s0 = (const bf16_t*)P.out + (size_t)DBG_PRE_OFF; bf16_t* d0 = (bf16_t*)(P.ws + WS_Y);
      for (size_t i = (size_t)blockIdx.x * NTHREADS + threadIdx.x; i < (size_t)M * DM; i += (size_t)gridDim.x * NTHREADS) d0[i] = s0[i];
      GSYNC(); }
#endif
    { const bf16_t* src = (const bf16_t*)(P.ws + (size_t)DBG_OFF); const float* srcf = (const float*)(P.ws + (size_t)DBG_OFF);
      for (size_t i = (size_t)blockIdx.x * NTHREADS + threadIdx.x; i < (size_t)M * DM; i += (size_t)gridDim.x * NTHREADS) {
#ifdef DBG_F32
        const float v = (i < (size_t)DBG_N) ? srcf[i] : 0.f;
#else
#ifdef DBG_LD
        const float v = bflo((unsigned)src[(i >> 10) * (size_t)DBG_LD + DBG_COL0 + (i & 1023)]);
#else
        const float v = bflo((unsigned)src[i]);
#endif
#endif
#ifdef DBG_NANDET
        P.out[i] = ((fabsf(v) < 1e30f) || (int)(i & 1023) < DBG_CMIN || (int)(i & 1023) >= DBG_CMAX) ? 0.f : 1e6f;
#else
        P.out[i] = v;
#endif
      } }
#endif
}
#if N_LAUNCH_SPLIT
__global__ void __launch_bounds__(NTHREADS, 2) fwd_phase(Params P, int ph) {
    extern __shared__ __attribute__((aligned(16))) unsigned char lds_raw[];
    LAS unsigned char* lds = (LAS unsigned char*)lds_raw;
    const int tid = threadIdx.x, lane = tid & 63, wave = __builtin_amdgcn_readfirstlane(tid >> 6);
    run_phase(P, lds, ph, tid, lane, wave);
}
#endif

extern "C" void kernel_launch(void* const* d_in, const int* in_sizes, int n_in, void* d_out, int out_size, void* d_ws, size_t ws_size, hipStream_t stream) {
    static int grid_blocks = 0;
    if (!grid_blocks) {
        int dev = 0, cus = 0, per_cu = 0;
        hipGetDevice(&dev);
        hipDeviceGetAttribute(&cus, hipDeviceAttributeMultiprocessorCount, dev);
        hipFuncSetAttribute((const void*)fwd_mega, hipFuncAttributeMaxDynamicSharedMemorySize, LDS_BYTES);
#if N_LAUNCH_SPLIT
        hipFuncSetAttribute((const void*)fwd_phase, hipFuncAttributeMaxDynamicSharedMemorySize, LDS_BYTES);
#endif
        if (hipOccupancyMaxActiveBlocksPerMultiprocessor(&per_cu, (const void*)fwd_mega, NTHREADS, LDS_BYTES) != hipSuccess || per_cu < 1) per_cu = 1;
        (void)hipGetLastError();
        if (cus <= 0) cus = 256;
        grid_blocks = cus * 1;
    }
    (void)hipMemsetAsync((unsigned char*)d_ws + WS_BAR, 0, 16 * KiB, stream);
    Params p{};
    for (int i = 0; i < 18; ++i) p.in[i] = (const float*)d_in[i];
    p.out = (float*)d_out; p.ws = (unsigned char*)d_ws;
#if N_LAUNCH_SPLIT
    for (int ph = 0; ph < NPHASE; ++ph) hipLaunchKernelGGL(fwd_phase, dim3(grid_blocks), dim3(NTHREADS), LDS_BYTES, stream, p, ph);
#else
    void* args[] = {&p};
    hipError_t e = hipLaunchCooperativeKernel((const void*)fwd_mega, dim3(grid_blocks), dim3(NTHREADS), args, LDS_BYTES, stream);
    if (e != hipSuccess) fprintf(stderr, "cooperative launch failed: %s (grid %d)\n", hipGetErrorString(e), grid_blocks);
#endif
}
```

```cpp
#include <hip/hip_runtime.h>
#include <hip/hip_cooperative_groups.h>
#include <cstdio>
#include <cstdint>
#include <cmath>
namespace cg = cooperative_groups;
namespace pg8 {
#define PG8_LAS __attribute__((address_space(3)))
typedef unsigned short bf16_t;
typedef short bf16x8 __attribute__((ext_vector_type(8)));
typedef float f32x4 __attribute__((ext_vector_type(4)));
typedef unsigned u32x4 __attribute__((ext_vector_type(4)));
constexpr int BM = 256, BK = 64, HALF = 128, HTB = HALF * BK * 2  , STAGE_BYTES = 8 * HTB, NXCD = 8, WGM = 8;

__host__ __device__ __forceinline__ int lds_byte(int r, int c) { const int st = (r >> 4) * 2 + (c >> 5), rr = r & 15, cc = c & 31, ob = rr * 64 + cc * 2; return st * 1024 + (ob ^ (((ob >> 9) & 1) << 5)); }
__host__ __device__ __forceinline__ void stage_rc(int b, int& R, int& C) { const int st = b / 1024, sb = b % 1024, swz = sb ^ (((sb >> 9) & 1) << 5); R = (st >> 1) * 16 + swz / 64; C = (st & 1) * 32 + (swz % 64) / 2; }
__host__ __device__ __forceinline__ int perm32(int rho) { const int n = rho >> 4, i = rho & 15; return 8 * (i >> 2) + 4 * n + (i & 3); }

struct Unit { int pm, pn; };
struct Gemm { const bf16_t* A; const bf16_t* Bt; int M, N, K; };

struct StaticOrder {
    int nM, nN, nwg, G, c;
    __host__ __device__ void init(int M, int N, int G_, int c_) { nM = M / BM; nN = N / BM; nwg = nM * nN; G = G_; c = c_; }
    __host__ __device__ bool next(int i, Unit& u) const {
        const long L = (long)i * G + c; if (L >= nwg) return false;
        int wgid = (int)L; { const int q = nwg / NXCD, r = nwg % NXCD, xcd = wgid % NXCD, off = wgid / NXCD; wgid = (xcd < r ? xcd * (q + 1) : r * (q + 1) + (xcd - r) * q) + off; }
        const int nig = WGM * nN, gid = wgid / nig, fm = gid * WGM, gsz = (nM - fm) < WGM ? (nM - fm) : WGM;
        u.pm = fm + ((wgid % nig) % gsz); u.pn = (wgid % nig) / gsz; return true;
    }
    __device__ __forceinline__ void a_ready(const Unit&) const {}
    __device__ __forceinline__ void done(const Unit&) const {}
};
typedef float cvt_f32x2 __attribute__((ext_vector_type(2)));
typedef __bf16 cvt_bf16x2 __attribute__((ext_vector_type(2)));
__device__ __forceinline__ unsigned cvt_pk_bf16(float lo, float hi) { const cvt_f32x2 v = {lo, hi}; const cvt_bf16x2 b = __builtin_convertvector(v, cvt_bf16x2); return __builtin_bit_cast(unsigned, b); }
typedef float f32x2 __attribute__((ext_vector_type(2)));
template <class Epi, class Sched, bool ALIGN_EPI = false, bool SP2 = false>
__device__ __forceinline__ void gemm_phase(PG8_LAS unsigned char* lds, const Gemm g, const Sched& S, const Epi& E, int tid_in) {
    int tid_raw = tid_in; asm volatile("" : "+v"(tid_raw));
    const int tid = tid_raw, wid = __builtin_amdgcn_readfirstlane(tid >> 6), lane = tid & 63, wr = wid >> 2, wc = wid & 3, fr = lane & 15, fq = lane >> 4;
    const int K = g.K, nt = K / BK;
    unsigned voffA[2], voffB[2];
#pragma unroll
    for (int i = 0; i < 2; ++i) { int R, C; stage_rc(tid * 16 + i * 8192, R, C); const int Rb = Epi::PERM ? ((R & ~31) + perm32(R & 31)) : R;
        voffA[i] = (unsigned)(R * K + C) * 2u; voffB[i] = (unsigned)(Rb * K + C) * 2u; }
    const size_t kstep = (size_t)(BK * 2);
    const size_t hstep = (size_t)HALF * K * 2;
    const size_t tstep = 2 * hstep;
    const unsigned ldsw = (unsigned)wid * 1024u;
    const int aoff = lds_byte(wr * 64 + fr, fq * 8), boff = lds_byte(wc * 32 + fr, fq * 8);
#define PG8_SA(b, h) (((b) * 2 + (h)) * HTB)
#define PG8_SB(b, h) ((4 + (b) * 2 + (h)) * HTB)
#define PG8_STAGE(bufoff, gbase, voff) do { _Pragma("unroll") for (int _i = 0; _i < 2; ++_i) \
        __builtin_amdgcn_global_load_lds((const unsigned*)((const char*)(gbase) + (voff)[_i]), (PG8_LAS unsigned*)(lds + (bufoff) + ldsw + _i * 8192), 16, 0, 0); } while (0)
#define PG8_LDA(dst, b, h) do { _Pragma("unroll") for (int m = 0; m < 4; ++m) _Pragma("unroll") for (int k = 0; k < 2; ++k) dst[m][k] = *(const PG8_LAS bf16x8*)(lds + PG8_SA(b, h) + aoff + m * 2048 + k * 1024); } while (0)
#define PG8_LDB(dst, b, h) do { _Pragma("unroll") for (int n = 0; n < 2; ++n) _Pragma("unroll") for (int k = 0; k < 2; ++k) dst[n][k] = *(const PG8_LAS bf16x8*)(lds + PG8_SB(b, h) + boff + n * 2048 + k * 1024); } while (0)
#define PG8_MMA(ai, bj, At, Bt) do { __builtin_amdgcn_s_setprio(1); _Pragma("unroll") for (int m = 0; m < 4; ++m) _Pragma("unroll") for (int n = 0; n < 2; ++n) _Pragma("unroll") for (int k = 0; k < 2; ++k) \
        acc[ai][bj][m][n] = __builtin_amdgcn_mfma_f32_16x16x32_bf16(Bt[n][k], At[m][k], acc[ai][bj][m][n], 0, 0, 0); __builtin_amdgcn_s_setprio(0); } while (0)
#define PG8_WAIT_V(n) asm volatile("s_waitcnt vmcnt(" #n ")" ::: "memory")
#define PG8_WAIT_L(n) asm volatile("s_waitcnt lgkmcnt(" #n ")" ::: "memory")
#define PG8_BAR __builtin_amdgcn_s_barrier()
#define PG8_SCHED __builtin_amdgcn_sched_barrier(0)
    Unit cur, nxt; int ui = 0;
    if (!S.next(0, cur)) return;
    f32x4 acc[2][2][4][2];
#pragma unroll
    for (int a = 0; a < 2; ++a)
#pragma unroll
        for (int b = 0; b < 2; ++b)
#pragma unroll
            for (int m = 0; m < 4; ++m)
#pragma unroll
                for (int n = 0; n < 2; ++n) acc[a][b][m][n] = (f32x4){0.f, 0.f, 0.f, 0.f};
    bf16x8 At[4][2], B0[2][2], B1[2][2];
    const char* cA = (const char*)g.A + (size_t)cur.pm * tstep; const char* cB = (const char*)g.Bt + (size_t)cur.pn * tstep;
    S.a_ready(cur);
    if constexpr (SP2) {
        PG8_STAGE(PG8_SB(0, 0), cB, voffB); PG8_STAGE(PG8_SB(0, 1), cB + hstep, voffB); PG8_STAGE(PG8_SA(0, 0), cA, voffA); PG8_STAGE(PG8_SA(0, 1), cA + hstep, voffA);
        if (wr == 1) PG8_BAR;
        PG8_WAIT_V(2); PG8_BAR;
        PG8_STAGE(PG8_SB(1, 0), cB + kstep, voffB); PG8_STAGE(PG8_SA(1, 0), cA + kstep, voffA); PG8_STAGE(PG8_SB(1, 1), cB + hstep + kstep, voffB);
        PG8_WAIT_V(6); PG8_BAR;
    } else {
        PG8_STAGE(PG8_SB(0, 0), cB, voffB); PG8_STAGE(PG8_SA(0, 0), cA, voffA); PG8_STAGE(PG8_SB(0, 1), cB + hstep, voffB); PG8_STAGE(PG8_SA(0, 1), cA + hstep, voffA);
        if (wr == 1) PG8_BAR;
        PG8_WAIT_V(4); PG8_BAR;
        PG8_STAGE(PG8_SB(1, 0), cB + kstep, voffB); PG8_STAGE(PG8_SA(1, 0), cA + kstep, voffA); PG8_STAGE(PG8_SB(1, 1), cB + hstep + kstep, voffB);
        PG8_WAIT_V(6); PG8_BAR;
    }
    for (;;) {
        const bool has_next = S.next(ui + 1, nxt);
        const char* nA = has_next ? (const char*)g.A + (size_t)nxt.pm * tstep : cA; const char* nB = has_next ? (const char*)g.Bt + (size_t)nxt.pn * tstep : cB;
        for (int t = 0; t < nt; t += 2) {
            const bool last = (t == nt - 2);
            const char* a1 = cA + (size_t)(t + 1) * kstep;
            const char* a2 = last ? nA : cA + (size_t)(t + 2) * kstep; const char* b2 = last ? nB : cB + (size_t)(t + 2) * kstep;
            const char* a3 = a2 + kstep; const char* b3 = b2 + kstep;
            if (last && has_next) S.a_ready(nxt);
            if constexpr (SP2) {
            PG8_LDB(B0, 0, 0); PG8_LDB(B1, 0, 1); PG8_SCHED; PG8_LDA(At, 0, 0); PG8_STAGE(PG8_SA(1, 1), a1 + hstep, voffA);
            PG8_WAIT_V(8); PG8_WAIT_L(0); PG8_BAR; PG8_MMA(0, 0, At, B0); PG8_MMA(0, 1, At, B1); PG8_BAR; PG8_SCHED;
            PG8_LDA(At, 0, 1); PG8_STAGE(PG8_SB(0, 0), b2, voffB); PG8_STAGE(PG8_SB(0, 1), b2 + hstep, voffB); PG8_STAGE(PG8_SA(0, 0), a2, voffA);
            PG8_WAIT_V(8); PG8_WAIT_L(0); PG8_BAR; PG8_MMA(1, 0, At, B0); PG8_MMA(1, 1, At, B1); PG8_BAR; PG8_SCHED;
            PG8_LDB(B0, 1, 0); PG8_LDB(B1, 1, 1); PG8_SCHED; PG8_LDA(At, 1, 0); PG8_STAGE(PG8_SA(0, 1), a2 + hstep, voffA);
            PG8_WAIT_V(8); PG8_WAIT_L(0); PG8_BAR; PG8_MMA(0, 0, At, B0); PG8_MMA(0, 1, At, B1); PG8_BAR; PG8_SCHED;
            PG8_LDA(At, 1, 1); PG8_STAGE(PG8_SB(1, 0), b3, voffB); PG8_STAGE(PG8_SB(1, 1), b3 + hstep, voffB); PG8_STAGE(PG8_SA(1, 0), a3, voffA);
            PG8_WAIT_V(8); PG8_WAIT_L(0); PG8_BAR; PG8_MMA(1, 0, At, B0); PG8_MMA(1, 1, At, B1); PG8_BAR; PG8_SCHED;
            } else {
            PG8_LDB(B0, 0, 0); PG8_SCHED; PG8_LDA(At, 0, 0); PG8_STAGE(PG8_SA(1, 1), a1 + hstep, voffA);
            PG8_WAIT_L(8); PG8_BAR; PG8_WAIT_L(0); PG8_MMA(0, 0, At, B0); PG8_BAR; PG8_SCHED;
            PG8_LDB(B1, 0, 1); PG8_STAGE(PG8_SB(0, 0), b2, voffB);
            PG8_BAR; PG8_WAIT_L(0); PG8_MMA(0, 1, At, B1); PG8_BAR;
            PG8_LDA(At, 0, 1); PG8_STAGE(PG8_SA(0, 0), a2, voffA);
            PG8_BAR; PG8_WAIT_L(0); PG8_MMA(1, 0, At, B0); PG8_BAR; PG8_SCHED;
            PG8_STAGE(PG8_SB(0, 1), b2 + hstep, voffB);
            PG8_WAIT_V(6); PG8_BAR; PG8_MMA(1, 1, At, B1); PG8_BAR;
            PG8_LDB(B0, 1, 0); PG8_SCHED; PG8_LDA(At, 1, 0); PG8_STAGE(PG8_SA(0, 1), a2 + hstep, voffA);
            PG8_WAIT_L(8); PG8_BAR; PG8_WAIT_L(0); PG8_MMA(0, 0, At, B0); PG8_BAR; PG8_SCHED;
            PG8_LDB(B1, 1, 1); PG8_STAGE(PG8_SB(1, 0), b3, voffB);
            PG8_BAR; PG8_WAIT_L(0); PG8_MMA(0, 1, At, B1); PG8_BAR;
            PG8_LDA(At, 1, 1); PG8_STAGE(PG8_SA(1, 0), a3, voffA);
            PG8_BAR; PG8_WAIT_L(0); PG8_MMA(1, 0, At, B0); PG8_BAR; PG8_SCHED;
            PG8_STAGE(PG8_SB(1, 1), b3 + hstep, voffB);
            PG8_WAIT_V(6); PG8_BAR; PG8_MMA(1, 1, At, B1); PG8_BAR;
            }
        }
        if constexpr (ALIGN_EPI) { if (wr == 0) PG8_BAR; }
        if constexpr (!Epi::AFTER_DRAIN) { E(acc, cur, wr, wc, fr, fq); S.done(cur); }
        if (!has_next) break;
#pragma unroll
        for (int a = 0; a < 2; ++a)
#pragma unroll
            for (int b = 0; b < 2; ++b)
#pragma unroll
                for (int m = 0; m < 4; ++m)
#pragma unroll
                    for (int n = 0; n < 2; ++n) acc[a][b][m][n] = (f32x4){0.f, 0.f, 0.f, 0.f};
        cur = nxt; cA = nA; cB = nB; ++ui;
        if constexpr (ALIGN_EPI) { if (wr == 1) PG8_BAR; }
    }
    PG8_WAIT_V(0);
    if constexpr (!ALIGN_EPI) { if (wr == 0) PG8_BAR; }
    PG8_BAR;
    if constexpr (Epi::AFTER_DRAIN) { E.fused(acc, cur, wr, wc, fr, fq, lds, wid, lane); S.done(cur); }
#undef PG8_SA
#undef PG8_SB
#undef PG8_STAGE
#undef PG8_LDA
#undef PG8_LDB
#undef PG8_MMA
#undef PG8_WAIT_V
#undef PG8_WAIT_L
#undef PG8_BAR
#undef PG8_SCHED
}
}

#define LAS __attribute__((address_space(3)))
typedef unsigned short bf16_t;
typedef short bf16x8 __attribute__((ext_vector_type(8)));
typedef float f32x4 __attribute__((ext_vector_type(4)));
typedef unsigned u32x4 __attribute__((ext_vector_type(4)));
typedef unsigned u32x2 __attribute__((ext_vector_type(2)));
using pg8::cvt_pk_bf16;

constexpr int M = 16384, SEQ = 8192, DM = 1024, DFF = 4096, DPLE = 256;
constexpr int NPROJ = 3840, PROJ_LD = 3072, NIN = 3600;
constexpr float RMS_EPS = 1e-6f;
constexpr int NTHREADS = 512, NWAVES = 8;
constexpr int LDS_BYTES = 163840;

constexpr size_t KiB = 1024, MiB = 1u << 20;
constexpr size_t WS_ROWSQ1 = 0, WS_ROWSQ2 = 64 * KiB, WS_FC = 128 * KiB, WS_MLOC = 132 * KiB, WS_MSTART = 136 * KiB;
constexpr size_t WS_BAR = 144 * KiB;
constexpr size_t WS_NLOC = 256 * KiB, WS_NSTART = 768 * KiB;
constexpr size_t WS_WIN = 2 * MiB, WS_WOUT = WS_WIN + (size_t)NPROJ * DM * 2, WS_WFF1 = WS_WOUT + 2 * MiB, WS_WFF2 = WS_WFF1 + 8 * MiB,
                 WS_WPG = WS_WFF2 + 8 * MiB, WS_WPU = WS_WPG + 2 * MiB;
constexpr size_t WS_XN = 30 * MiB;
constexpr size_t WS_PU = 62 * MiB, WS_Y = 94 * MiB, WS_HID = 126 * MiB;
constexpr size_t WS_PROJ = 126 * MiB, WS_VTN = 222 * MiB, WS_PB = 238 * MiB, WS_GATES = 246 * MiB, WS_END = 254 * MiB;
static_assert(WS_WPU + 512 * KiB <= WS_XN, "weights fit");

struct Params { const float* in[18]; float* out; unsigned char* ws; };
enum { I_X = 0, I_P, I_N1G, I_WIN, I_CONVW, I_CONVB, I_GATEB, I_MNG, I_QNG, I_KNG, I_RPB, I_WOUT, I_N2G, I_WFF1, I_WFF2, I_PNG, I_WPG, I_WPU };

__device__ __forceinline__ float bflo(unsigned u) { return __uint_as_float(u << 16); }
__device__ __forceinline__ float bfhi(unsigned u) { return __uint_as_float(u & 0xffff0000u); }
__device__ __forceinline__ unsigned short f2bf(float f) { return (unsigned short)(cvt_pk_bf16(f, 0.f) & 0xffffu); }
__device__ __forceinline__ float sigmoidf_(float x) { return __builtin_amdgcn_rcpf(1.0f + __expf(-x)); }
__device__ __forceinline__ float wave_sum_all(float v) {
#pragma unroll
    for (int o = 1; o < 64; o <<= 1) v += __shfl_xor(v, o);
    return v;
}
__device__ __forceinline__ float wave_max_all(float v) {
#pragma unroll
    for (int o = 1; o < 64; o <<= 1) v = fmaxf(v, __shfl_xor(v, o));
    return v;
}
__device__ __forceinline__ float wave_incl_sum(float v, int lane) {
#pragma unroll
    for (int o = 1; o < 64; o <<= 1) { float t = __shfl_up(v, o); if (lane >= o) v += t; }
    return v;
}
__device__ __forceinline__ float wave_incl_max(float v, int lane) {
#pragma unroll
    for (int o = 1; o < 64; o <<= 1) { float t = __shfl_up(v, o); if (lane >= o) v = fmaxf(v, t); }
    return v;
}

#ifndef EPI_NT
#define EPI_NT 0
#endif
#if EPI_NT
#define EPI_ST16(p, v) __builtin_nontemporal_store((v), (u32x4*)(p))
#define EPI_ST8(p, v) __builtin_nontemporal_store((v), (u32x2*)(p))
#else
#define EPI_ST16(p, v) (*(u32x4*)(p) = (v))
#define EPI_ST8(p, v) (*(u32x2*)(p) = (v))
#endif
struct EpiInProj {
    static constexpr bool PERM = true, AFTER_DRAIN = false;
    bf16_t* proj; bf16_t* vtn; float* gates; const float* gate_b;
    __device__ __forceinline__ void operator()(const f32x4 (&acc)[2][2][4][2], const pg8::Unit& u, int wr, int wc, int fr, int fq) const {
        const int row0 = u.pm * 256 + wr * 64 + fr;
        if (u.pn < 12) {
            const int col0 = u.pn * 256 + wc * 32 + 8 * fq;
#pragma unroll
            for (int ai = 0; ai < 2; ++ai)
#pragma unroll
                for (int m = 0; m < 4; ++m) { bf16_t* rowp = proj + (size_t)(row0 + ai * 128 + m * 16) * PROJ_LD + col0;
#pragma unroll
                    for (int bj = 0; bj < 2; ++bj) { const f32x4 v0 = acc[ai][bj][m][0], v1 = acc[ai][bj][m][1]; u32x4 w;
                        w.x = cvt_pk_bf16(v0[0], v0[1]); w.y = cvt_pk_bf16(v0[2], v0[3]); w.z = cvt_pk_bf16(v1[0], v1[1]); w.w = cvt_pk_bf16(v1[2], v1[3]);
                        EPI_ST16(rowp + bj * 128, w); } }
        } else if (u.pn < 14) {
            const int b = row0 >> 13, s0 = row0 & 8191;
            bf16_t* vb = vtn + ((size_t)(b * 512 + (u.pn - 12) * 256 + wc * 32 + 8 * fq)) * SEQ + s0;
#pragma unroll
            for (int bj = 0; bj < 2; ++bj)
#pragma unroll
                for (int n = 0; n < 2; ++n)
#pragma unroll
                    for (int i = 0; i < 4; ++i) { bf16_t* vp = vb + (size_t)(bj * 128 + 4 * n + i) * SEQ;
#pragma unroll
                        for (int ai = 0; ai < 2; ++ai)
#pragma unroll
                            for (int m = 0; m < 4; ++m) vp[ai * 128 + m * 16] = f2bf(acc[ai][bj][m][n][i]); }
        } else {
            if (wc == 0 && fq < 2) {
#pragma unroll
                for (int ai = 0; ai < 2; ++ai)
#pragma unroll
                    for (int m = 0; m < 4; ++m) { const int row = row0 + ai * 128 + m * 16;
#pragma unroll
                        for (int n = 0; n < 2; ++n) { f32x4 o;
#pragma unroll
                            for (int i = 0; i < 4; ++i) { const int c = 8 * fq + 4 * n + i; float v = acc[ai][0][m][n][i] + gate_b[c];
                                if ((c >> 2) & 1) v = fminf(v, 0.f) - log1pf(__expf(-fabsf(v)));
                                o[i] = v; }
                            *(f32x4*)(gates + (size_t)row * 16 + 8 * fq + 4 * n) = o; } }
            }
        }
    }
};
struct EpiBf16Plain {
    static constexpr bool PERM = true, AFTER_DRAIN = false;
    bf16_t* O; int ldc;
    __device__ __forceinline__ void operator()(const f32x4 (&acc)[2][2][4][2], const pg8::Unit& u, int wr, int wc, int fr, int fq) const {
        const int row0 = u.pm * 256 + wr * 64 + fr, col0 = u.pn * 256 + wc * 32 + 8 * fq;
#pragma unroll
        for (int ai = 0; ai < 2; ++ai)
#pragma unroll
            for (int m = 0; m < 4; ++m) { bf16_t* rowp = O + (size_t)(row0 + ai * 128 + m * 16) * ldc + col0;
#pragma unroll
                for (int bj = 0; bj < 2; ++bj) { const f32x4 v0 = acc[ai][bj][m][0], v1 = acc[ai][bj][m][1]; u32x4 w;
                    w.x = cvt_pk_bf16(v0[0], v0[1]); w.y = cvt_pk_bf16(v0[2], v0[3]); w.z = cvt_pk_bf16(v1[0], v1[1]); w.w = cvt_pk_bf16(v1[2], v1[3]);
                    __builtin_nontemporal_store(w, (u32x4*)(rowp + bj * 128)); } }
    }
};
struct EpiRelu2 {
    static constexpr bool PERM = true, AFTER_DRAIN = false;
    bf16_t* O; const float* rowsq;
    __device__ __forceinline__ void operator()(const f32x4 (&acc)[2][2][4][2], const pg8::Unit& u, int wr, int wc, int fr, int fq) const {
        const int row0 = u.pm * 256 + wr * 64 + fr, col0 = u.pn * 256 + wc * 32 + 8 * fq;
#pragma unroll
        for (int ai = 0; ai < 2; ++ai)
#pragma unroll
            for (int m = 0; m < 4; ++m) { const int row = row0 + ai * 128 + m * 16; bf16_t* rowp = O + (size_t)row * DFF + col0;
                const float r2 = __builtin_amdgcn_rcpf(rowsq[row] * (1.0f / DM) + RMS_EPS);
#pragma unroll
                for (int bj = 0; bj < 2; ++bj) { f32x4 v0 = acc[ai][bj][m][0], v1 = acc[ai][bj][m][1];
#pragma unroll
                    for (int i = 0; i < 4; ++i) { float a = fmaxf(v0[i], 0.f), b = fmaxf(v1[i], 0.f); v0[i] = a * a * r2; v1[i] = b * b * r2; }
                    u32x4 w; w.x = cvt_pk_bf16(v0[0], v0[1]); w.y = cvt_pk_bf16(v0[2], v0[3]); w.z = cvt_pk_bf16(v1[0], v1[1]); w.w = cvt_pk_bf16(v1[2], v1[3]);
                    EPI_ST16(rowp + bj * 128, w); } }
    }
};
struct EpiResid {
    static constexpr bool PERM = true, AFTER_DRAIN = false;
    const float* base; const bf16_t* baseb; bf16_t* outb; float* rowsq;
    __device__ __forceinline__ void operator()(const f32x4 (&acc)[2][2][4][2], const pg8::Unit& u, int wr, int wc, int fr, int fq) const {
        const int row0 = u.pm * 256 + wr * 64 + fr, col0 = u.pn * 256 + wc * 32 + 8 * fq;
#pragma unroll
        for (int ai = 0; ai < 2; ++ai)
#pragma unroll
            for (int m = 0; m < 4; ++m) { const int row = row0 + ai * 128 + m * 16; const size_t off = (size_t)row * DM + col0; float ss = 0.f;
#pragma unroll
                for (int bj = 0; bj < 2; ++bj) { const size_t o2 = off + bj * 128; f32x4 b0, b1;
                    if (base) { b0 = __builtin_nontemporal_load((const f32x4*)(base + o2)); b1 = __builtin_nontemporal_load((const f32x4*)(base + o2 + 4)); }
                    else { const u32x4 bw = __builtin_nontemporal_load((const u32x4*)(baseb + o2)); b0 = (f32x4){bflo(bw.x), bfhi(bw.x), bflo(bw.y), bfhi(bw.y)}; b1 = (f32x4){bflo(bw.z), bfhi(bw.z), bflo(bw.w), bfhi(bw.w)}; }
                    const f32x4 o0 = b0 + acc[ai][bj][m][0], o1 = b1 + acc[ai][bj][m][1];
                    u32x4 w; w.x = cvt_pk_bf16(o0[0], o0[1]); w.y = cvt_pk_bf16(o0[2], o0[3]); w.z = cvt_pk_bf16(o1[0], o1[1]); w.w = cvt_pk_bf16(o1[2], o1[3]); *(u32x4*)(outb + o2) = w;
                    ss += ((o0[0] * o0[0] + o0[1] * o0[1]) + (o0[2] * o0[2] + o0[3] * o0[3])) + ((o1[0] * o1[0] + o1[1] * o1[1]) + (o1[2] * o1[2] + o1[3] * o1[3])); }
                ss += __shfl_xor(ss, 16); ss += __shfl_xor(ss, 32);
                if (fq == 0) atomicAdd(rowsq + row, ss); }
    }
};
struct EpiPle {
    static constexpr bool PERM = true, AFTER_DRAIN = false;
    const bf16_t* h; float* out; const bf16_t* pu; const float* rowsq;
    __device__ __forceinline__ void operator()(const f32x4 (&acc)[2][2][4][2], const pg8::Unit& u, int wr, int wc, int fr, int fq) const {
        const int row0 = u.pm * 256 + wr * 64 + fr, col0 = u.pn * 256 + wc * 32 + 8 * fq;
#pragma unroll
        for (int ai = 0; ai < 2; ++ai)
#pragma unroll
            for (int m = 0; m < 4; ++m) { const int row = row0 + ai * 128 + m * 16; const size_t off = (size_t)row * DM + col0;
                const float r = rsqrtf(rowsq[row] * (1.0f / DM) + RMS_EPS);
#pragma unroll
                for (int bj = 0; bj < 2; ++bj) { const size_t o2 = off + bj * 128; const u32x4 hw = __builtin_nontemporal_load((const u32x4*)(h + o2)); const u32x4 pw = __builtin_nontemporal_load((const u32x4*)(pu + o2));
#pragma unroll
                    for (int n = 0; n < 2; ++n) { const f32x4 a = acc[ai][bj][m][n]; const unsigned h0 = n ? hw.z : hw.x, h1 = n ? hw.w : hw.y, p0 = n ? pw.z : pw.x, p1 = n ? pw.w : pw.y; f32x4 o;
                        o[0] = bflo(h0) + sigmoidf_(r * a[0]) * bflo(p0); o[1] = bfhi(h0) + sigmoidf_(r * a[1]) * bfhi(p0);
                        o[2] = bflo(h1) + sigmoidf_(r * a[2]) * bflo(p1); o[3] = bfhi(h1) + sigmoidf_(r * a[3]) * bfhi(p1);
                        __builtin_nontemporal_store(o, (f32x4*)(out + o2 + 4 * n)); } } }
    }
};

struct PuOrder {
    int c;
    __device__ __forceinline__ bool next(int i, pg8::Unit& u) const { if (c < 129) return false; const int idx = (c - 129) + 127 * i; if (idx >= 256) return false; u.pm = idx >> 2; u.pn = idx & 3; return true; }
    __device__ __forceinline__ void a_ready(const pg8::Unit&) const {}
    __device__ __forceinline__ void done(const pg8::Unit&) const {}
};
__device__ __forceinline__ void p0_transpose_item(const float* W, int ldw, int coff, int K, int nblk, const float* gain, bf16_t* WT, int row_off, LAS float* scr, int item, int lane) {
    const int kb = item / nblk, nb = item % nblk, k0 = 64 * kb, n0 = 32 * nb;
    float wv[32];
#pragma unroll
    for (int i = 0; i < 32; ++i) { const int kk = 2 * i + (lane >> 5); wv[i] = __builtin_nontemporal_load(W + (size_t)(k0 + kk) * ldw + coff + n0 + (lane & 31)); }
#pragma unroll
    for (int i = 0; i < 32; ++i) { const int kk = 2 * i + (lane >> 5); float v = wv[i]; if (gain) v *= gain[k0 + kk]; scr[kk * 33 + (lane & 31)] = v; }
    asm volatile("s_waitcnt lgkmcnt(0)" ::: "memory");
    const int c = lane & 7;
#pragma unroll
    for (int j = 0; j < 4; ++j) { const int n = (lane >> 3) + 8 * j; const LAS float* s = scr + (8 * c) * 33 + n;
        u32x4 o; o.x = cvt_pk_bf16(s[0 * 33], s[1 * 33]); o.y = cvt_pk_bf16(s[2 * 33], s[3 * 33]); o.z = cvt_pk_bf16(s[4 * 33], s[5 * 33]); o.w = cvt_pk_bf16(s[6 * 33], s[7 * 33]);
        *(u32x4*)(WT + (size_t)(row_off + n0 + n) * K + k0 + 8 * c) = o; }
    asm volatile("s_waitcnt lgkmcnt(0)" ::: "memory");
}
__device__ __forceinline__ void transposes_early(const Params& P, LAS float* scr, int gw, int NGW, int lane) {
    unsigned char* ws = P.ws;
    constexpr int I0 = 16 * 64, I1 = 16 * 48, I2 = 16, I7 = 4 * 32;
    for (int it = gw; it < I0 + I1 + I2 + I7; it += NGW) {
        int r = it;
        if (r < I0) { p0_transpose_item(P.in[I_WIN], NIN, 0, DM, 64, nullptr, (bf16_t*)(ws + WS_WIN), 0, scr, r, lane); continue; } r -= I0;
        if (r < I1) { p0_transpose_item(P.in[I_WIN], NIN, 2064, DM, 48, nullptr, (bf16_t*)(ws + WS_WIN), 2048, scr, r, lane); continue; } r -= I1;
        if (r < I2) { p0_transpose_item(P.in[I_WIN], NIN, 2048, DM, 1, nullptr, (bf16_t*)(ws + WS_WIN), 3584, scr, r, lane); continue; } r -= I2;
        p0_transpose_item(P.in[I_WPU], DM, 0, DPLE, 32, nullptr, (bf16_t*)(ws + WS_WPU), 0, scr, r, lane);
    }
}
__device__ __forceinline__ void transposes_late(const Params& P, LAS float* scr, int gw, int NGW, int lane) {
    unsigned char* ws = P.ws;
    constexpr int I3 = 16 * 32, I4 = 16 * 128, I5 = 64 * 32, I6 = 16 * 32;
    for (int it = gw; it < I3 + I4 + I5 + I6; it += NGW) {
        int r = it;
        if (r < I3) { p0_transpose_item(P.in[I_WOUT], DM, 0, DM, 32, nullptr, (bf16_t*)(ws + WS_WOUT), 0, scr, r, lane); continue; } r -= I3;
        if (r < I4) { p0_transpose_item(P.in[I_WFF1], DFF, 0, DM, 128, P.in[I_N2G], (bf16_t*)(ws + WS_WFF1), 0, scr, r, lane); continue; } r -= I4;
        if (r < I5) { p0_transpose_item(P.in[I_WFF2], DM, 0, DFF, 32, nullptr, (bf16_t*)(ws + WS_WFF2), 0, scr, r, lane); continue; } r -= I5;
        p0_transpose_item(P.in[I_WPG], DM, 0, DM, 32, P.in[I_PNG], (bf16_t*)(ws + WS_WPG), 0, scr, r, lane);
    }
}
__device__ __forceinline__ void phase_prologue(const Params& P, LAS unsigned char* lds, int tid, int lane, int wave) {
    unsigned char* ws = P.ws;
    LAS float* scr = (LAS float*)(lds + wave * 16384);
    const int gw = blockIdx.x * NWAVES + wave, NGW = gridDim.x * NWAVES;
    transposes_early(P, scr, gw, NGW, lane);
    if (gridDim.x != 256) transposes_late(P, scr, gw, NGW, lane);
    const float* x = P.in[I_X]; const float* g1 = P.in[I_N1G]; const float* pp = P.in[I_P];
    bf16_t* XN = (bf16_t*)(ws + WS_XN); bf16_t* PB = (bf16_t*)(ws + WS_PB);
    for (int m0 = gw; m0 < M; m0 += 4 * NGW) {
        f32x4 v[4][4]; f32x4 pv[4]; float s[4];
#pragma unroll
        for (int u = 0; u < 4; ++u) { const int m = m0 + u * NGW; const f32x4* xr = (const f32x4*)(x + (size_t)m * DM) + lane;
#pragma unroll
            for (int j = 0; j < 4; ++j) v[u][j] = __builtin_nontemporal_load(xr + 64 * j);
            pv[u] = __builtin_nontemporal_load((const f32x4*)(pp + (size_t)m * DPLE) + lane); }
#pragma unroll
        for (int u = 0; u < 4; ++u) { s[u] = 0.f;
#pragma unroll
            for (int j = 0; j < 4; ++j) s[u] += (v[u][j][0] * v[u][j][0] + v[u][j][1] * v[u][j][1]) + (v[u][j][2] * v[u][j][2] + v[u][j][3] * v[u][j][3]); }
#pragma unroll
        for (int u = 0; u < 4; ++u) { const int m = m0 + u * NGW; const float rstd = rsqrtf(wave_sum_all(s[u]) * (1.f / DM) + RMS_EPS);
            u32x2* o8 = (u32x2*)(XN + (size_t)m * DM) + lane;
#pragma unroll
            for (int j = 0; j < 4; ++j) { const f32x4 g = *((const f32x4*)g1 + lane + 64 * j); u32x2 w; w.x = cvt_pk_bf16(v[u][j][0] * rstd * g[0], v[u][j][1] * rstd * g[1]); w.y = cvt_pk_bf16(v[u][j][2] * rstd * g[2], v[u][j][3] * rstd * g[3]); o8[64 * j] = w; }
            u32x2 w; w.x = cvt_pk_bf16(pv[u][0], pv[u][1]); w.y = cvt_pk_bf16(pv[u][2], pv[u][3]);
            *((u32x2*)(PB + (size_t)m * DPLE) + lane) = w; }
    }
    float* rs = (float*)(ws + WS_ROWSQ1);
    for (int i = blockIdx.x * NTHREADS + tid; i < 2 * M; i += gridDim.x * NTHREADS) rs[i] = 0.f;
}

__device__ __forceinline__ int tsw(int row, int s) { return row * 136 + ((((s >> 3) ^ (row >> 3)) & 15) << 3) + (s & 7); }

struct ConvW { float w[3][8]; float b[8]; };
__device__ __forceinline__ void load_convw(ConvW& c, const float* conv_w, const float* conv_b, int ch) {
#pragma unroll
    for (int t = 0; t < 3; ++t) { const f32x4 a = *(const f32x4*)(conv_w + t * 1024 + ch), b = *(const f32x4*)(conv_w + t * 1024 + ch + 4);
#pragma unroll
        for (int j = 0; j < 4; ++j) { c.w[t][j] = a[j]; c.w[t][4 + j] = b[j]; } }
    const f32x4 a = *(const f32x4*)(conv_b + ch), b = *(const f32x4*)(conv_b + ch + 4);
#pragma unroll
    for (int j = 0; j < 4; ++j) { c.b[j] = a[j]; c.b[4 + j] = b[j]; }
}
__device__ __forceinline__ void conv_silu8(const bf16_t* rowp, int p, const ConvW& c, float (&y)[8]) {
    const u32x4 z = {0u, 0u, 0u, 0u};
    const u32x4 x0 = *(const u32x4*)rowp;
    const u32x4 xm = (p > 0) ? *(const u32x4*)(rowp - PROJ_LD) : z;
    const u32x4 xp = (p < SEQ - 1) ? *(const u32x4*)(rowp + PROJ_LD) : z;
#pragma unroll
    for (int q = 0; q < 4; ++q) {
        float a = c.w[0][2 * q] * bflo(xm[q]) + c.w[1][2 * q] * bflo(x0[q]) + c.w[2][2 * q] * bflo(xp[q]) + c.b[2 * q];
        float b = c.w[0][2 * q + 1] * bfhi(xm[q]) + c.w[1][2 * q + 1] * bfhi(x0[q]) + c.w[2][2 * q + 1] * bfhi(xp[q]) + c.b[2 * q + 1];
        y[2 * q] = a * sigmoidf_(a); y[2 * q + 1] = b * sigmoidf_(b);
    }
}

struct Raw3 { u32x4 xm, x0, xp; };
template <bool NT> __device__ __forceinline__ u32x4 ld16(const bf16_t* p) { if constexpr (NT) return __builtin_nontemporal_load((const u32x4*)p); else return *(const u32x4*)p; }
template <bool NT = false> __device__ __forceinline__ Raw3 conv_load3(const bf16_t* rowp, int p) { Raw3 r; const u32x4 z = {0u, 0u, 0u, 0u};
    r.x0 = ld16<NT>(rowp); r.xm = (p > 0) ? ld16<NT>(rowp - PROJ_LD) : z; r.xp = (p < SEQ - 1) ? ld16<NT>(rowp + PROJ_LD) : z; return r; }
__device__ __forceinline__ void conv_apply8(const Raw3& r, const ConvW& c, float (&y)[8]) {
#pragma unroll
    for (int q = 0; q < 4; ++q) {
        float a = c.w[0][2 * q] * bflo(r.xm[q]) + c.w[1][2 * q] * bflo(r.x0[q]) + c.w[2][2 * q] * bflo(r.xp[q]) + c.b[2 * q];
        float b = c.w[0][2 * q + 1] * bfhi(r.xm[q]) + c.w[1][2 * q + 1] * bfhi(r.x0[q]) + c.w[2][2 * q + 1] * bfhi(r.xp[q]) + c.b[2 * q + 1];
        y[2 * q] = a * sigmoidf_(a); y[2 * q + 1] = b * sigmoidf_(b);
    }
}
constexpr int ML_A0 = 0, ML_A1 = 34816, ML_A2 = 69632, ML_ARR = 104448;

__device__ __forceinline__ void phase_mlstm_a(const Params& P, LAS unsigned char* lds, int tid0, int lane0, int wave) {
    unsigned char* ws = P.ws;
    const bf16_t* proj = (const bf16_t*)(ws + WS_PROJ); const float* gates = (const float*)(ws + WS_GATES);
    bf16_t* cloc = (bf16_t*)P.out; float* nloc = (float*)(ws + WS_NLOC); float* FC = (float*)(ws + WS_FC); float* MLOC = (float*)(ws + WS_MLOC);
    LAS bf16_t* VT = (LAS bf16_t*)(lds + ML_A0); LAS bf16_t* KW0 = (LAS bf16_t*)(lds + ML_A1); LAS bf16_t* KW1 = (LAS bf16_t*)(lds + ML_A2);
    LAS float* arr = (LAS float*)(lds + ML_ARR);
    for (int item = blockIdx.x; item < 512; item += gridDim.x) {
        int tid = tid0; asm volatile("" : "+v"(tid));
        const int lane = tid & 63, fr = lane & 15, fq = lane >> 4; (void)lane0;
        const int bh = item >> 6, T = item & 63, b = bh >> 2, h = bh & 3; const int tok0 = b * SEQ + T * 128;
        Raw3 rk[4]; u32x4 rv[4];
#pragma unroll
        for (int i = 0; i < 4; ++i) { const int s_ = (tid >> 4) + 32 * i; const bf16_t* rowp = proj + (size_t)(tok0 + s_) * PROJ_LD + h * 128 + 8 * (tid & 15);
            rk[i] = conv_load3(rowp + 512, T * 128 + s_); rv[i] = *(const u32x4*)(rowp + 1024); }
        if (tid < 128) { const float* g = gates + (size_t)(tok0 + tid) * 16 + h;
            arr[128 + tid] = g[0]; arr[tid] = g[4]; arr[384 + tid] = g[8]; arr[256 + tid] = g[12]; }
        __syncthreads();
        if (wave < 2) { const bool rev = wave == 1; const LAS float* lf = arr + (rev ? 256 : 0); const LAS float* ii = arr + (rev ? 384 : 128);
            const int p0 = 2 * lane, p1 = p0 + 1, i0 = rev ? 127 - p0 : p0, i1 = rev ? 127 - p1 : p1;
            const float x0 = lf[i0], x1 = lf[i1]; const float inc = wave_incl_sum(x0 + x1, lane); const float F = __shfl(inc, 63);
            const float a0 = ii[i0] + F - (inc - x1), a1 = ii[i1] + F - inc; const float ml = wave_max_all(fmaxf(a0, a1));
            arr[512 + wave * 128 + i0] = __expf(a0 - ml); arr[512 + wave * 128 + i1] = __expf(a1 - ml);
            if (lane == 0) { FC[(bh * 2 + wave) * 64 + T] = F; MLOC[(bh * 2 + wave) * 64 + T] = ml; } }
        __syncthreads();
        { const int dg = tid & 15, d0 = 8 * dg, srow = tid >> 4; ConvW cw; load_convw(cw, P.in[I_CONVW], P.in[I_CONVB], 512 + h * 128 + d0);
#pragma unroll
            for (int i = 0; i < 4; ++i) { const int s = srow + 32 * i; const bf16_t* rowp = proj + (size_t)(tok0 + s) * PROJ_LD;
                float y[8]; conv_apply8(rk[i], cw, y); (void)rowp;
                const u32x4 vv = rv[i];
                const float wf = arr[512 + s] * 0.08838834764831845f, wb = arr[640 + s] * 0.08838834764831845f;
#pragma unroll
                for (int j = 0; j < 8; ++j) { const int o = tsw(d0 + j, s); KW0[o] = f2bf(y[j] * wf); KW1[o] = f2bf(y[j] * wb);
                    VT[o] = (bf16_t)((j & 1) ? (vv[j >> 1] >> 16) : (vv[j >> 1] & 0xffffu)); } } }
        __syncthreads();
#pragma unroll
        for (int dir = 0; dir < 2; ++dir) { const LAS bf16_t* KW = dir ? KW1 : KW0;
            f32x4 acc[9];
#pragma unroll
            for (int t = 0; t < 9; ++t) acc[t] = (f32x4){0.f, 0.f, 0.f, 0.f};
#pragma unroll
            for (int kk = 0; kk < 4; ++kk) { const bf16x8 af = *(const LAS bf16x8*)(KW + tsw(16 * wave + fr, 32 * kk + 8 * fq));
#pragma unroll
                for (int t = 0; t < 8; ++t) { const bf16x8 bfr = *(const LAS bf16x8*)(VT + tsw(16 * t + fr, 32 * kk + 8 * fq)); acc[t] = __builtin_amdgcn_mfma_f32_16x16x32_bf16(af, bfr, acc[t], 0, 0, 0); }
                const short one = (fr == 0) ? (short)0x3F80 : (short)0; const bf16x8 ones = {one, one, one, one, one, one, one, one};
                acc[8] = __builtin_amdgcn_mfma_f32_16x16x32_bf16(af, ones, acc[8], 0, 0, 0); }
            const int st = bh * 2 + dir; bf16_t* cl = cloc + ((size_t)(st * 64 + T)) * 16384;
#pragma unroll
            for (int t = 0; t < 8; ++t) { u32x2 w; w.x = cvt_pk_bf16(acc[t][0], acc[t][1]); w.y = cvt_pk_bf16(acc[t][2], acc[t][3]); *(u32x2*)(cl + (16 * t + fr) * 128 + 16 * wave + 4 * fq) = w; }
            if (fr == 0) *(f32x4*)(nloc + (size_t)(st * 64 + T) * 128 + 16 * wave + 4 * fq) = acc[8]; }
        __syncthreads();
    }
}

__device__ __forceinline__ void phase_mlstm_b(const Params& P, int tid) {
    unsigned char* ws = P.ws;
    const bf16_t* cloc = (const bf16_t*)P.out; bf16_t* cstart = (bf16_t*)P.out + (size_t)16 * 1024 * 1024;
    const float* nloc = (const float*)(ws + WS_NLOC); float* nstart = (float*)(ws + WS_NSTART);
    const float* FC = (const float*)(ws + WS_FC); const float* MLOC = (const float*)(ws + WS_MLOC); float* MSTART = (float*)(ws + WS_MSTART);
    const int nth = gridDim.x * NTHREADS;
    for (int it = blockIdx.x * NTHREADS + tid; it < 65536 + 512; it += nth) {
        const bool is_main = it < 65536; const int st = is_main ? (it >> 12) : ((it - 65536) >> 5); const int e4 = is_main ? (it & 4095) * 4 : ((it - 65536) & 31) * 4; const int dir = st & 1; const int stu = is_main ? __builtin_amdgcn_readfirstlane(st) : st;
        float m = 0.f; f32x4 C = {0.f, 0.f, 0.f, 0.f};
        for (int c0 = 0; c0 < 64; c0 += 16) {
            f32x4 v[16]; float Fv[16], Mv[16];
#pragma unroll
            for (int k = 0; k < 16; ++k) { const int T = dir ? 63 - (c0 + k) : c0 + k;
                if (is_main) { const u32x2 w = __builtin_nontemporal_load((const u32x2*)(cloc + (size_t)(st * 64 + T) * 16384 + e4)); v[k] = (f32x4){bflo(w.x), bfhi(w.x), bflo(w.y), bfhi(w.y)}; }
                else v[k] = __builtin_nontemporal_load((const f32x4*)(nloc + (size_t)(st * 64 + T) * 128 + e4));
                Fv[k] = FC[stu * 64 + T]; Mv[k] = MLOC[stu * 64 + T]; }
#pragma unroll
            for (int k = 0; k < 16; ++k) { const int T = dir ? 63 - (c0 + k) : c0 + k;
                if (is_main) { u32x2 w; w.x = cvt_pk_bf16(C[0], C[1]); w.y = cvt_pk_bf16(C[2], C[3]); *(u32x2*)(cstart + (size_t)(st * 64 + T) * 16384 + e4) = w; }
                else { *(f32x4*)(nstart + (size_t)(st * 64 + T) * 128 + e4) = C; if (e4 == 0) MSTART[st * 64 + T] = m; }
                const float mn = fmaxf(m + Fv[k], Mv[k]); const float wp = __expf(m + Fv[k] - mn), wl = __expf(Mv[k] - mn);
                C = C * wp + v[k] * wl; m = mn; }
        }
    }
}

__device__ __forceinline__ void phase_mlstm_c(const Params& P, LAS unsigned char* lds, int tid0, int lane0, int wave) {
    unsigned char* ws = P.ws;
    const bf16_t* proj = (const bf16_t*)(ws + WS_PROJ); const float* gates = (const float*)(ws + WS_GATES);
    const bf16_t* cstart = (const bf16_t*)P.out + (size_t)16 * 1024 * 1024; const float* nstart = (const float*)(ws + WS_NSTART); const float* MSTART = (const float*)(ws + WS_MSTART);
    bf16_t* Y = (bf16_t*)(ws + WS_Y); const float* mng = P.in[I_MNG];
    LAS bf16_t* QS = (LAS bf16_t*)(lds + ML_A0); LAS bf16_t* KS = (LAS bf16_t*)(lds + ML_A1); LAS bf16_t* VT = (LAS bf16_t*)(lds + ML_A2);
    LAS float* arr = (LAS float*)(lds + ML_ARR);
    LAS bf16_t* CL0 = (LAS bf16_t*)(lds + ML_ARR + 6144);
    for (int item = blockIdx.x; item < 512; item += gridDim.x) {
        int tid = tid0; asm volatile("" : "+v"(tid));
        const int lane = tid & 63, fr = lane & 15, fq = lane >> 4; (void)lane0;
        const int bh = item >> 6, T = item & 63, b = bh >> 2, h = bh & 3; const int tok0 = b * SEQ + T * 128;
        Raw3 rq[4], rk[4]; u32x4 rv[4];
#pragma unroll
        for (int i = 0; i < 4; ++i) { const int s_ = (tid >> 4) + 32 * i; const bf16_t* rowp = proj + (size_t)(tok0 + s_) * PROJ_LD + h * 128 + 8 * (tid & 15);
            rq[i] = conv_load3<true>(rowp, T * 128 + s_); rk[i] = conv_load3<true>(rowp + 512, T * 128 + s_); rv[i] = ld16<true>(rowp + 1024); }
        if (tid < 128) { const float* g = gates + (size_t)(tok0 + tid) * 16 + h;
            arr[128 + tid] = g[0]; arr[tid] = g[4]; arr[384 + tid] = g[8]; arr[256 + tid] = g[12]; }
        u32x4 c0v[4], c1v[4];
#pragma unroll
        for (int i = 0; i < 4; ++i) { const int id = tid + 512 * i; c0v[i] = __builtin_nontemporal_load((const u32x4*)(cstart + (size_t)((bh * 2 + 0) * 64 + T) * 16384 + id * 8)); c1v[i] = __builtin_nontemporal_load((const u32x4*)(cstart + (size_t)((bh * 2 + 1) * 64 + T) * 16384 + id * 8)); }
        __syncthreads();
        if (wave < 2) { const bool rev = wave == 1; const LAS float* lf = arr + (rev ? 256 : 0); const LAS float* ii = arr + (rev ? 384 : 128); LAS float* o = arr + 512 + wave * 512;
            const float ms = MSTART[(bh * 2 + wave) * 64 + T];
            const int p0 = 2 * lane, p1 = p0 + 1, i0 = rev ? 127 - p0 : p0, i1 = rev ? 127 - p1 : p1;
            const float x0 = lf[i0], x1 = lf[i1]; const float inc = wave_incl_sum(x0 + x1, lane); const float cb0 = inc - x1, cb1 = inc;
            const float u0 = ii[i0] - cb0, u1 = ii[i1] - cb1; const float incm = wave_incl_max(fmaxf(u0, u1), lane);
            float exm = __shfl_up(incm, 1); if (lane == 0) exm = -INFINITY;
            const float n0 = fmaxf(ms, fmaxf(exm, u0)), n1 = fmaxf(ms, incm);
            o[i0] = u0 * 1.4426950408889634f; o[i1] = u1 * 1.4426950408889634f; o[128 + i0] = n0 * 1.4426950408889634f; o[128 + i1] = n1 * 1.4426950408889634f;     o[256 + i0] = __expf(ms - n0); o[256 + i1] = __expf(ms - n1);
            o[384 + i0] = __expf(-(cb0 + n0)); o[384 + i1] = __expf(-(cb1 + n1)); }
        { const int dg = tid & 15, d0 = 8 * dg, srow = tid >> 4; ConvW cq, ck; load_convw(cq, P.in[I_CONVW], P.in[I_CONVB], h * 128 + d0); load_convw(ck, P.in[I_CONVW], P.in[I_CONVB], 512 + h * 128 + d0);
#pragma unroll
            for (int i = 0; i < 4; ++i) { const int s = srow + 32 * i; const bf16_t* rowp = proj + (size_t)(tok0 + s) * PROJ_LD;
                float yq[8], yk[8]; conv_apply8(rq[i], cq, yq); conv_apply8(rk[i], ck, yk); (void)rowp;
                const u32x4 vv = rv[i];
                u32x4 wq, wk; const float ksc = 0.08838834764831845f;
                wq.x = cvt_pk_bf16(yq[0], yq[1]); wq.y = cvt_pk_bf16(yq[2], yq[3]); wq.z = cvt_pk_bf16(yq[4], yq[5]); wq.w = cvt_pk_bf16(yq[6], yq[7]);
                wk.x = cvt_pk_bf16(yk[0] * ksc, yk[1] * ksc); wk.y = cvt_pk_bf16(yk[2] * ksc, yk[3] * ksc); wk.z = cvt_pk_bf16(yk[4] * ksc, yk[5] * ksc); wk.w = cvt_pk_bf16(yk[6] * ksc, yk[7] * ksc);
                *(LAS u32x4*)(QS + s * 136 + d0) = wq; *(LAS u32x4*)(KS + s * 136 + d0) = wk;
#pragma unroll
                for (int j = 0; j < 8; ++j) VT[tsw(d0 + j, s)] = (bf16_t)((j & 1) ? (vv[j >> 1] >> 16) : (vv[j >> 1] & 0xffffu)); } }
#pragma unroll
        for (int i = 0; i < 4; ++i) { const int id = tid + 512 * i; *(LAS u32x4*)(CL0 + (id >> 4) * 136 + (id & 15) * 8) = c0v[i]; }
        __syncthreads();
        bf16x8 qf[4];
#pragma unroll
        for (int kk = 0; kk < 4; ++kk) qf[kk] = *(const LAS bf16x8*)(QS + (16 * wave + fr) * 136 + 32 * kk + 8 * fq);
        __syncthreads();
#pragma unroll
        for (int i = 0; i < 4; ++i) { const int id = tid + 512 * i; *(LAS u32x4*)(QS + (id >> 4) * 136 + (id & 15) * 8) = c1v[i]; }
        u32x2 owv[8];
#pragma unroll
        for (int t = 0; t < 8; ++t) owv[t] = __builtin_nontemporal_load((const u32x2*)(proj + (size_t)(tok0 + 16 * wave + fr) * PROJ_LD + 1536 + h * 128 + 16 * t + 4 * fq));
        f32x4 sraw[8];
#pragma unroll
        for (int t = 0; t < 8; ++t) { f32x4 sa = {0.f, 0.f, 0.f, 0.f};
#pragma unroll
            for (int kk = 0; kk < 4; ++kk) { const bf16x8 kf = *(const LAS bf16x8*)(KS + (16 * t + fr) * 136 + 32 * kk + 8 * fq); sa = __builtin_amdgcn_mfma_f32_16x16x32_bf16(kf, qf[kk], sa, 0, 0, 0); }
            sraw[t] = sa; if (t & 1) __builtin_amdgcn_sched_barrier(0); }
        f32x4 hsum[8];
        const int l = 16 * wave + fr;
        {
#pragma unroll
        for (int t = 0; t < 8; ++t) hsum[t] = (f32x4){0.f, 0.f, 0.f, 0.f};
#pragma unroll 1
        for (int dir = 0; dir < 2; ++dir) {
            int lane_ = lane; asm volatile("" : "+v"(lane_));
            const int fr_ = lane_ & 15, fq_ = lane_ >> 4, l_ = 16 * wave + fr_;
            if (dir == 1) __syncthreads();
            const LAS bf16_t* CL = dir ? QS : CL0;
            const LAS float* o = arr + 512 + dir * 512; const float nl = o[128 + l_], wi = o[256 + l_], ei = o[384 + l_];
            const int st = bh * 2 + dir;
            unsigned pk[8][2];
#pragma unroll
            for (int t = 0; t < 8; ++t) {
                const bool t_all = dir ? (t > wave) : (t < wave); const bool t_diag = (t == wave);
                f32x4 sa = sraw[t];
                const f32x4 us = *(const LAS f32x4*)(o + 16 * t + 4 * fq_);
#pragma unroll
                for (int i = 0; i < 4; ++i) { const int dq = 4 * fq_ + i - fr_; const bool ok = t_all || (t_diag && (dir ? (dq >= 0) : (dq <= 0))); sa[i] = ok ? sa[i] * __builtin_amdgcn_exp2f(fminf(us[i] - nl, 0.f)) : 0.f; }
                pk[t][0] = cvt_pk_bf16(sa[0], sa[1]); pk[t][1] = cvt_pk_bf16(sa[2], sa[3]);
                if (t & 1) __builtin_amdgcn_sched_barrier(0); }
            f32x4 na[9];
#pragma unroll
            for (int t = 0; t < 9; ++t) na[t] = (f32x4){0.f, 0.f, 0.f, 0.f};
            const float* ns = nstart + (size_t)(st * 64 + T) * 128;
#pragma unroll
            for (int kk = 0; kk < 4; ++kk) {
#pragma unroll
                for (int t = 0; t < 8; ++t) { const bf16x8 cf = *(const LAS bf16x8*)(CL + (16 * t + fr_) * 136 + 32 * kk + 8 * fq_); na[t] = __builtin_amdgcn_mfma_f32_16x16x32_bf16(cf, qf[kk], na[t], 0, 0, 0); }
                u32x4 nw = {0u, 0u, 0u, 0u};
                if (fr_ == 0) { const f32x4 a = *(const f32x4*)(ns + 32 * kk + 8 * fq_), bb = *(const f32x4*)(ns + 32 * kk + 8 * fq_ + 4);
                    nw.x = cvt_pk_bf16(a[0], a[1]); nw.y = cvt_pk_bf16(a[2], a[3]); nw.z = cvt_pk_bf16(bb[0], bb[1]); nw.w = cvt_pk_bf16(bb[2], bb[3]); }
                na[8] = __builtin_amdgcn_mfma_f32_16x16x32_bf16(__builtin_bit_cast(bf16x8, nw), qf[kk], na[8], 0, 0, 0);
                __builtin_amdgcn_sched_barrier(0); }
#pragma unroll
            for (int t = 0; t < 9; ++t) na[t] = na[t] * wi;
#pragma unroll
            for (int kk = 0; kk < 4; ++kk) {
                u32x4 pw; pw.x = pk[2 * kk][0]; pw.y = pk[2 * kk][1]; pw.z = pk[2 * kk + 1][0]; pw.w = pk[2 * kk + 1][1]; const bf16x8 pf = __builtin_bit_cast(bf16x8, pw);
#pragma unroll
                for (int t = 0; t < 8; ++t) { const u32x2 a0 = *(const LAS u32x2*)(VT + tsw(16 * t + fr_, 32 * kk + 4 * fq_)), a1 = *(const LAS u32x2*)(VT + tsw(16 * t + fr_, 32 * kk + 16 + 4 * fq_));
                    u32x4 aw; aw.x = a0.x; aw.y = a0.y; aw.z = a1.x; aw.w = a1.y; na[t] = __builtin_amdgcn_mfma_f32_16x16x32_bf16(__builtin_bit_cast(bf16x8, aw), pf, na[t], 0, 0, 0); }
                const short one = (fr_ == 0) ? (short)0x3F80 : (short)0; const bf16x8 ones = {one, one, one, one, one, one, one, one};
                na[8] = __builtin_amdgcn_mfma_f32_16x16x32_bf16(ones, pf, na[8], 0, 0, 0);
                __builtin_amdgcn_sched_barrier(0); }
            const float den = __shfl(na[8][0], fr_); const float inv = __builtin_amdgcn_rcpf(fmaxf(fabsf(den), ei));
#pragma unroll
            for (int t = 0; t < 8; ++t) hsum[t] = hsum[t] + na[t] * inv;
        }
        }
        float ss = 0.f;
#pragma unroll
        for (int t = 0; t < 8; ++t) ss += (hsum[t][0] * hsum[t][0] + hsum[t][1] * hsum[t][1]) + (hsum[t][2] * hsum[t][2] + hsum[t][3] * hsum[t][3]);
        ss += __shfl_xor(ss, 16); ss += __shfl_xor(ss, 32);
        const float rstd = rsqrtf(ss * (1.0f / 128.0f) + RMS_EPS);
        const size_t tok = (size_t)(tok0 + l);
#pragma unroll
        for (int t = 0; t < 8; ++t) { const int e = 16 * t + 4 * fq; const f32x4 g = *(const f32x4*)(mng + h * 128 + e); const u32x2 ow = owv[t];
            const float y0 = hsum[t][0] * rstd * g[0] * sigmoidf_(bflo(ow.x)), y1 = hsum[t][1] * rstd * g[1] * sigmoidf_(bfhi(ow.x)),
                        y2 = hsum[t][2] * rstd * g[2] * sigmoidf_(bflo(ow.y)), y3 = hsum[t][3] * rstd * g[3] * sigmoidf_(bfhi(ow.y));
            u32x2 w; w.x = cvt_pk_bf16(y0, y1); w.y = cvt_pk_bf16(y2, y3); *(u32x2*)(Y + tok * DM + h * 128 + e) = w; }
        __syncthreads();
    }
}

constexpr int NA_K = 0, NA_V = 73728, NA_TAB = 140288, NA_EX = 142208;
struct NaRow { u32x4 k, v; };
__device__ __forceinline__ NaRow na_load(const bf16_t* proj, const bf16_t* vtn, int b, int h, int g, int tid) {
    const int col = tid >> 3, ch = tid & 7; NaRow x;
    x.k = *(const u32x4*)(proj + ((size_t)(b * SEQ + g * 64 + col)) * PROJ_LD + 2560 + h * 64 + 8 * ch);
    x.v = *(const u32x4*)(vtn + ((size_t)((b * 8 + h) * 64 + col)) * SEQ + g * 64 + 8 * ch);
    return x;
}
__device__ __forceinline__ void na_store(const NaRow& x, int slot, LAS unsigned char* lds, int tid) {
    const int col = tid >> 3, ch = tid & 7; float v[8]; float ss = 0.f;
#pragma unroll
    for (int q = 0; q < 4; ++q) { v[2 * q] = bflo(x.k[q]); v[2 * q + 1] = bfhi(x.k[q]); ss += v[2 * q] * v[2 * q] + v[2 * q + 1] * v[2 * q + 1]; }
    ss += __shfl_xor(ss, 1); ss += __shfl_xor(ss, 2); ss += __shfl_xor(ss, 4);
    const float rk = rsqrtf(ss * (1.0f / 64.0f) + RMS_EPS); u32x4 w;
    w.x = cvt_pk_bf16(v[0] * rk, v[1] * rk); w.y = cvt_pk_bf16(v[2] * rk, v[3] * rk); w.z = cvt_pk_bf16(v[4] * rk, v[5] * rk); w.w = cvt_pk_bf16(v[6] * rk, v[7] * rk);
    *(LAS u32x4*)(lds + NA_K + ((slot * 64 + col) * 72 + 8 * ch) * 2) = w;
    *(LAS u32x4*)(lds + NA_V + (col * 520 + slot * 64 + 8 * ch) * 2) = x.v;
}
__device__ __forceinline__ void phase_natten2(const Params& P, LAS unsigned char* lds, int tid0, int wave) {
    unsigned char* ws = P.ws;
    const bf16_t* proj = (const bf16_t*)(ws + WS_PROJ); const bf16_t* vtn = (const bf16_t*)(ws + WS_VTN); bf16_t* Y = (bf16_t*)(ws + WS_Y);
    const float* qg = P.in[I_QNG]; const float* kg = P.in[I_KNG]; const float* rpb = P.in[I_RPB];
    LAS float* tab = (LAS float*)(lds + NA_TAB); LAS float* ex = (LAS float*)(lds + NA_EX);
    const LAS bf16_t* KL = (const LAS bf16_t*)(lds + NA_K); const LAS bf16_t* VL = (const LAS bf16_t*)(lds + NA_V);
    for (int run = blockIdx.x; run < 256; run += gridDim.x) {
        int tid = tid0; asm volatile("" : "+v"(tid));
        const int lane = tid & 63, fr = lane & 15, fq = lane >> 4;
        const int bh = run >> 4, b = bh >> 3, h = bh & 7, r0 = (run & 15) * 8;
        const int j = wave & 3, half = wave >> 2;
        if (tid < 480) { const int ro = tid >> 5, co = tid & 31; tab[tid] = (co < 31) ? rpb[(h * 15 + ro) * 31 + co] * 1.4426950408889634f : -INFINITY; }
        const int c0 = min(max(16 * j - 8, 0), 32), c = 16 * j + fr, cs = min(max(c - 8, 0), 48);
        int coidx[2][4];
#pragma unroll
        for (int hh = 0; hh < 2; ++hh)
#pragma unroll
            for (int i = 0; i < 4; ++i) { const int cc = c0 + 16 * hh + 4 * fq + i; const bool ok = (cc >= cs) && (cc < cs + 16); coidx[hh][i] = ok ? (cc - c + 15) : 31; }
        float gqk[16];
#pragma unroll
        for (int kk = 0; kk < 2; ++kk) { const int d = h * 64 + 32 * kk + 8 * fq;
            const f32x4 ga = *(const f32x4*)(qg + d), gb = *(const f32x4*)(qg + d + 4), ka = *(const f32x4*)(kg + d), kb = *(const f32x4*)(kg + d + 4);
#pragma unroll
            for (int q = 0; q < 4; ++q) { gqk[8 * kk + q] = ga[q] * ka[q] * (0.125f * 1.4426950408889634f); gqk[8 * kk + 4 + q] = gb[q] * kb[q] * (0.125f * 1.4426950408889634f); } }
        int rs = min(max(r0 - 4, 0), 120);
#pragma unroll
        for (int gg = 0; gg < 8; ++gg) { const NaRow x = na_load(proj, vtn, b, h, rs + gg, tid); na_store(x, (rs + gg) & 7, lds, tid); }
        int hi = rs + 7;
        u32x4 qw[2];
#pragma unroll
        for (int kk = 0; kk < 2; ++kk) qw[kk] = ld16<true>(proj + ((size_t)b * SEQ + r0 * 64 + c) * PROJ_LD + 2048 + h * 64 + 32 * kk + 8 * fq);
#pragma unroll 1
        for (int r = r0; r < r0 + 8; ++r) {
            rs = min(max(r - 4, 0), 120);
            __syncthreads();
            const int rsn = min(max(r - 3, 0), 120); const bool pre = (r + 1 < r0 + 8) && (rsn + 7 > hi);
            NaRow nx; nx.k = (u32x4){0u, 0u, 0u, 0u}; nx.v = nx.k; if (pre) nx = na_load(proj, vtn, b, h, rsn + 7, tid);
            const size_t tokq = (size_t)b * SEQ + r * 64 + c;
            bf16x8 qf[2];
            { u32x4 w[2]; float v[16]; float ss = 0.f;
#pragma unroll
                for (int kk = 0; kk < 2; ++kk) { w[kk] = qw[kk];
#pragma unroll
                    for (int q = 0; q < 4; ++q) { v[8 * kk + 2 * q] = bflo(w[kk][q]); v[8 * kk + 2 * q + 1] = bfhi(w[kk][q]); } }
#pragma unroll
                for (int q = 0; q < 16; ++q) ss += v[q] * v[q];
                ss += __shfl_xor(ss, 16); ss += __shfl_xor(ss, 32);
                const float rq = rsqrtf(ss * (1.0f / 64.0f) + RMS_EPS);
#pragma unroll
                for (int kk = 0; kk < 2; ++kk) { u32x4 o;
                    o.x = cvt_pk_bf16(v[8 * kk + 0] * rq * gqk[8 * kk + 0], v[8 * kk + 1] * rq * gqk[8 * kk + 1]); o.y = cvt_pk_bf16(v[8 * kk + 2] * rq * gqk[8 * kk + 2], v[8 * kk + 3] * rq * gqk[8 * kk + 3]);
                    o.z = cvt_pk_bf16(v[8 * kk + 4] * rq * gqk[8 * kk + 4], v[8 * kk + 5] * rq * gqk[8 * kk + 5]); o.w = cvt_pk_bf16(v[8 * kk + 6] * rq * gqk[8 * kk + 6], v[8 * kk + 7] * rq * gqk[8 * kk + 7]);
                    qf[kk] = __builtin_bit_cast(bf16x8, o); } }
            { const int rn = (r + 1 < r0 + 8) ? r + 1 : r;
#pragma unroll
              for (int kk = 0; kk < 2; ++kk) qw[kk] = ld16<true>(proj + ((size_t)b * SEQ + rn * 64 + c) * PROJ_LD + 2048 + h * 64 + 32 * kk + 8 * fq); }
            float mx, sum; f32x4 oa[4];
            {
            f32x4 sc[8]; mx = -INFINITY;
#pragma unroll
            for (int kr = 0; kr < 4; ++kr) { const int g = rs + 4 * half + kr, slot = g & 7, ro = g - r + 7;
#pragma unroll
                for (int hh = 0; hh < 2; ++hh) { const int t = 2 * kr + hh; const LAS bf16_t* kp = KL + (slot * 64 + c0 + 16 * hh + fr) * 72 + 8 * fq;
                    const bf16x8 k0 = *(const LAS bf16x8*)kp, k1 = *(const LAS bf16x8*)(kp + 32);
                    f32x4 sa = {0.f, 0.f, 0.f, 0.f};
                    sa = __builtin_amdgcn_mfma_f32_16x16x32_bf16(k0, qf[0], sa, 0, 0, 0);
                    sa = __builtin_amdgcn_mfma_f32_16x16x32_bf16(k1, qf[1], sa, 0, 0, 0);
#pragma unroll
                    for (int i = 0; i < 4; ++i) { const float v = sa[i] + tab[ro * 32 + coidx[hh][i]]; sc[t][i] = v; mx = fmaxf(mx, v); } } }
            mx = fmaxf(mx, __shfl_xor(mx, 16)); mx = fmaxf(mx, __shfl_xor(mx, 32));
            sum = 0.f; unsigned pk[8][2];
#pragma unroll
            for (int t = 0; t < 8; ++t) { f32x4 e;
#pragma unroll
                for (int i = 0; i < 4; ++i) { e[i] = __builtin_amdgcn_exp2f(sc[t][i] - mx); sum += e[i]; }
                pk[t][0] = cvt_pk_bf16(e[0], e[1]); pk[t][1] = cvt_pk_bf16(e[2], e[3]); }
            sum += __shfl_xor(sum, 16); sum += __shfl_xor(sum, 32);
#pragma unroll
            for (int nt = 0; nt < 4; ++nt) oa[nt] = (f32x4){0.f, 0.f, 0.f, 0.f};
#pragma unroll
            for (int kr = 0; kr < 4; ++kr) { const int slot = (rs + 4 * half + kr) & 7;
                u32x4 pw; pw.x = pk[2 * kr][0]; pw.y = pk[2 * kr][1]; pw.z = pk[2 * kr + 1][0]; pw.w = pk[2 * kr + 1][1]; const bf16x8 pf = __builtin_bit_cast(bf16x8, pw);
#pragma unroll
                for (int nt = 0; nt < 4; ++nt) { const LAS bf16_t* vp = VL + (16 * nt + fr) * 520 + slot * 64 + c0 + 4 * fq;
                    const u32x2 a0 = *(const LAS u32x2*)vp, a1 = *(const LAS u32x2*)(vp + 16); u32x4 aw; aw.x = a0.x; aw.y = a0.y; aw.z = a1.x; aw.w = a1.y;
                    oa[nt] = __builtin_amdgcn_mfma_f32_16x16x32_bf16(__builtin_bit_cast(bf16x8, aw), pf, oa[nt], 0, 0, 0); } }
            }
            if (half == 1) {
#pragma unroll
                for (int nt = 0; nt < 4; ++nt)
#pragma unroll
                    for (int i = 0; i < 4; ++i) ex[((4 * nt + i) * 4 + j) * 64 + lane] = oa[nt][i];
                ex[(16 * 4 + j) * 64 + lane] = mx; ex[(17 * 4 + j) * 64 + lane] = sum; }
            __syncthreads();
            if (pre) { na_store(nx, (rsn + 7) & 7, lds, tid); hi = rsn + 7; }
            if (half == 0) {
                const float m1 = ex[(16 * 4 + j) * 64 + lane], s1 = ex[(17 * 4 + j) * 64 + lane];
                const float m = fmaxf(mx, m1), f0 = __builtin_amdgcn_exp2f(mx - m), f1 = __builtin_amdgcn_exp2f(m1 - m); const float inv = __builtin_amdgcn_rcpf(sum * f0 + s1 * f1); const float g0 = f0 * inv, g1 = f1 * inv;
#pragma unroll
                for (int nt = 0; nt < 4; ++nt) { float o[4];
#pragma unroll
                    for (int i = 0; i < 4; ++i) o[i] = oa[nt][i] * g0 + ex[((4 * nt + i) * 4 + j) * 64 + lane] * g1;
                    u32x2 w; w.x = cvt_pk_bf16(o[0], o[1]); w.y = cvt_pk_bf16(o[2], o[3]);
                    __builtin_nontemporal_store(w, (u32x2*)(Y + tokq * DM + 512 + h * 64 + 16 * nt + 4 * fq)); } }
        }
        __syncthreads();
    }
}

#define GAS __attribute__((address_space(1)))
#define RLX_AGENT __ATOMIC_RELAXED, __HIP_MEMORY_SCOPE_AGENT
#define XB_TMO      128
#define XB_XCNT(j)  (256  + 64 * (j))
#define XB_XSUB(j)  (1280 + 64 * (j))
#define XB_XGEN(j)  (2304 + 64 * (j))
#define XB_TOP      3328
#define XB_TOPGEN   3392
#define XCD_BAR_WORDS 3456
#define XB_SPIN_CAP (1u << 18)

__device__ __forceinline__ unsigned xb_ld(unsigned* p)              { return __hip_atomic_load(p, __ATOMIC_RELAXED, __HIP_MEMORY_SCOPE_AGENT); }
__device__ __forceinline__ unsigned xb_add(unsigned* p, unsigned v) { return __hip_atomic_fetch_add(p, v, __ATOMIC_RELAXED, __HIP_MEMORY_SCOPE_AGENT); }
__device__ __forceinline__ unsigned xb_xcc_id() { return (unsigned)__builtin_amdgcn_s_getreg((3 << 11) | 20) & 0xFu; }
#define XB_SPIN(cond, bar) do { unsigned _sp = 0; while (cond) { __builtin_amdgcn_s_sleep(1); \
    if ((++_sp & 255u) == 0u) { if (xb_ld(&(bar)[XB_TMO])) break; if (_sp > XB_SPIN_CAP) { atomicAdd(&(bar)[XB_TMO], 1u); break; } } } } while (0)

struct XcdBarrier {
    unsigned* bar; unsigned x;
    volatile LAS unsigned* st;
};

__device__ __forceinline__ XcdBarrier xcd_barrier_post(unsigned* bar, volatile LAS unsigned* st) {
    XcdBarrier b; b.bar = bar; b.x = xb_xcc_id(); b.st = st;
    if (threadIdx.x == 0) (void)xb_add(&bar[XB_XCNT(b.x)], 1u);
    return b;
}
__device__ __forceinline__ void xcd_barrier_complete(unsigned* bar, unsigned x, unsigned& nloc, unsigned& nx) {
    const unsigned G = gridDim.x * gridDim.y * gridDim.z;
    unsigned sum, cnt, mine, sp = 0u;
    for (;;) {
        sum = 0u; cnt = 0u; mine = 0u;
#pragma unroll
        for (unsigned j = 0; j < 16; ++j) { const unsigned c = xb_ld(&bar[XB_XCNT(j)]); sum += c; cnt += (c > 0u) ? 1u : 0u; mine = (j == x) ? c : mine; }
        if (sum == G) break;
        __builtin_amdgcn_s_sleep(1);
        if ((++sp & 255u) == 0u) { if (xb_ld(&bar[XB_TMO])) break; if (sp > XB_SPIN_CAP) { atomicAdd(&bar[XB_TMO], 1u); break; } }
    }
    nloc = mine > 0u ? mine : 1u; nx = cnt > 0u ? cnt : 1u;
}

__device__ __forceinline__ void xcd_barrier(const XcdBarrier& b) {
    asm volatile("s_waitcnt vmcnt(0)" ::: "memory");
    __syncthreads();
    if (threadIdx.x == 0) {
        unsigned* bar = b.bar;
        __builtin_amdgcn_s_waitcnt(0);
        unsigned nloc = b.st[0], nx = b.st[1];
        if (nloc == 0u) { xcd_barrier_complete(bar, b.x, nloc, nx); b.st[0] = nloc; b.st[1] = nx; }
        const unsigned old = xb_add(&bar[XB_XSUB(b.x)], 1u);
        const unsigned gen = old / nloc;
        if (old + 1u == (gen + 1u) * nloc) {
            __builtin_amdgcn_fence(__ATOMIC_RELEASE, "agent");
            asm volatile("s_waitcnt vmcnt(0)" ::: "memory");
            const unsigned og = xb_add(&bar[XB_TOP], 1u);
            const unsigned tg = og / nx;
            if (og + 1u == (tg + 1u) * nx) xb_add(&bar[XB_TOPGEN], 1u);
            else XB_SPIN(xb_ld(&bar[XB_TOPGEN]) == tg, bar);
            __builtin_amdgcn_fence(__ATOMIC_ACQUIRE, "agent");
            xb_add(&bar[XB_XGEN(b.x)], 1u);
            asm volatile("s_waitcnt vmcnt(0)" ::: "memory");
        } else {
            XB_SPIN(xb_ld(&bar[XB_XGEN(b.x)]) == gen, bar);
            __builtin_amdgcn_fence(__ATOMIC_ACQUIRE, "agent");
            asm volatile("s_waitcnt vmcnt(0)" ::: "memory");
        }
    }
    __syncthreads();
}
#ifndef N_LAUNCH_SPLIT
#define N_LAUNCH_SPLIT 0
#endif
__device__ __forceinline__ void run_phase(const Params& P, LAS unsigned char* lds, int ph, int tid, int lane, int wave) {
    unsigned char* ws = P.ws;
    const int G = gridDim.x, c = blockIdx.x;
    if (ph == 0) phase_prologue(P, lds, tid, lane, wave);
    else if (ph == 1) {
        { pg8::Gemm g{(const bf16_t*)(ws + WS_XN), (const bf16_t*)(ws + WS_WIN), M, NPROJ, DM}; pg8::StaticOrder S; S.init(M, NPROJ, G, c);
          EpiInProj E{(bf16_t*)(ws + WS_PROJ), (bf16_t*)(ws + WS_VTN), (float*)(ws + WS_GATES), P.in[I_GATEB]};
          pg8::gemm_phase<EpiInProj, pg8::StaticOrder, true, true>(lds, g, S, E, tid); }
        if (G == 256 && c >= 192) { __syncthreads(); transposes_late(P, (LAS float*)(lds + wave * 16384), (c - 192) * NWAVES + wave, 64 * NWAVES, lane); }
    } else if (ph == 2) { phase_mlstm_a(P, lds, tid, lane, wave); phase_natten2(P, lds, tid, wave); }
    else if (ph == 20) phase_natten2(P, lds, tid, wave);
    else if (ph == 21) phase_mlstm_a(P, lds, tid, lane, wave);
    else if (ph == 3) { phase_mlstm_b(P, tid);
        { int kple = DPLE; asm volatile("" : "+s"(kple));
          pg8::Gemm g{(const bf16_t*)(ws + WS_PB), (const bf16_t*)(ws + WS_WPU), M, DM, kple};
          EpiBf16Plain E{(bf16_t*)(ws + WS_PU), DM};
          if (G == 256) { PuOrder S{c}; pg8::gemm_phase<EpiBf16Plain, PuOrder, true, true>(lds, g, S, E, tid); }
          else { pg8::StaticOrder S; S.init(M, DM, G, c); pg8::gemm_phase<EpiBf16Plain, pg8::StaticOrder, true, true>(lds, g, S, E, tid); } }
    }
    else if (ph == 4) phase_mlstm_c(P, lds, tid, lane, wave);
    else if (ph == 5) { pg8::Gemm g{(const bf16_t*)(ws + WS_Y), (const bf16_t*)(ws + WS_WOUT), M, DM, DM}; pg8::StaticOrder S; S.init(M, DM, G, c);
        EpiResid E{P.in[I_X], nullptr, (bf16_t*)(ws + WS_XN), (float*)(ws + WS_ROWSQ1)};
        pg8::gemm_phase<EpiResid, pg8::StaticOrder, true, true>(lds, g, S, E, tid); }
    else if (ph == 50) { pg8::Gemm g{(const bf16_t*)(ws + WS_Y), (const bf16_t*)(ws + WS_WOUT), M, DM, DM}; pg8::StaticOrder S; S.init(M, DM, G, c);
        EpiResid E{P.in[I_X], nullptr, (bf16_t*)(ws + WS_XN), (float*)(ws + WS_NLOC)};
        pg8::gemm_phase<EpiResid, pg8::StaticOrder, true, true>(lds, g, S, E, tid); }
    else if (ph == 6) { pg8::Gemm g{(const bf16_t*)(ws + WS_XN), (const bf16_t*)(ws + WS_WFF1), M, DFF, DM}; pg8::StaticOrder S; S.init(M, DFF, G, c);
        EpiRelu2 E{(bf16_t*)(ws + WS_HID), (const float*)(ws + WS_ROWSQ1)};
        pg8::gemm_phase<EpiRelu2, pg8::StaticOrder, true, true>(lds, g, S, E, tid); }
    else if (ph == 7) { pg8::Gemm g{(const bf16_t*)(ws + WS_HID), (const bf16_t*)(ws + WS_WFF2), M, DM, DFF}; pg8::StaticOrder S; S.init(M, DM, G, c);
        EpiResid E{nullptr, (const bf16_t*)(ws + WS_XN), (bf16_t*)(ws + WS_XN), (float*)(ws + WS_ROWSQ2)};
        pg8::gemm_phase<EpiResid, pg8::StaticOrder, true, true>(lds, g, S, E, tid); }
    else if (ph == 8) { pg8::Gemm g{(const bf16_t*)(ws + WS_XN), (const bf16_t*)(ws + WS_WPG), M, DM, DM}; pg8::StaticOrder S; S.init(M, DM, G, c);
        EpiPle E{(const bf16_t*)(ws + WS_XN), P.out, (const bf16_t*)(ws + WS_PU), (const float*)(ws + WS_ROWSQ2)};
        pg8::gemm_phase<EpiPle, pg8::StaticOrder, true, true>(lds, g, S, E, tid); }
}
constexpr int NPHASE = 9;

__global__ void __launch_bounds__(NTHREADS, 2) fwd_mega(Params P) {
    extern __shared__ __attribute__((aligned(16))) unsigned char lds_raw[];
    LAS unsigned char* lds = (LAS unsigned char*)lds_raw;
    cg::grid_group grid = cg::this_grid();
    const int tid = threadIdx.x, lane = tid & 63, wave = __builtin_amdgcn_readfirstlane(tid >> 6); const int wave_s = wave; (void)lane;
    volatile LAS unsigned* bst = (volatile LAS unsigned*)(lds + 163840 - 64);
    if (tid < 2) bst[tid] = 0u;
    __syncthreads();
    XcdBarrier xbar = xcd_barrier_post((unsigned*)(P.ws + WS_BAR), bst);
    if (P.ws == nullptr) grid.sync();
#define GSYNC() xcd_barrier(xbar)
#if defined(__HIP_DEVICE_COMPILE__)
#define RUNP(k) do { const __attribute__((address_space(4))) Params* pp = (const __attribute__((address_space(4))) Params*)__builtin_amdgcn_kernarg_segment_ptr(); \
        asm volatile("" : "+s"(pp)); Params Pl; __builtin_memcpy(&Pl, (const Params*)pp, sizeof(Params)); int t_ = threadIdx.x; asm volatile("" : "+v"(t_)); \
        run_phase(Pl, lds, (k), t_, t_ & 63, __builtin_amdgcn_readfirstlane(t_ >> 6)); } while (0)
#else
#define RUNP(k) run_phase(P, lds, (k), tid, lane, wave)
#endif
#ifndef DBG_STOP
#ifdef DBL_PHASE
#define DBL(k) do { if (DBL_PHASE == (k)) { RUNP(k); GSYNC(); } } while (0)
#else
#define DBL(k) do { } while (0)
#endif
#ifdef EXTRA_SYNCS
    for (int es = 0; es < EXTRA_SYNCS; ++es) GSYNC();
#endif
    DBL(0); RUNP(0); GSYNC(); DBL(1); RUNP(1); GSYNC(); DBL(20); DBL(21); DBL(2); RUNP(2); GSYNC(); DBL(3); RUNP(3); GSYNC(); DBL(4); RUNP(4); GSYNC(); DBL(50); RUNP(5); GSYNC(); DBL(6); RUNP(6); GSYNC(); RUNP(7); GSYNC(); RUNP(8);
#else
    RUNP(0); GSYNC();
    if (DBG_STOP >= 1) { RUNP(1); GSYNC(); }
    if (DBG_STOP >= 2) { RUNP(2); GSYNC(); }
    if (DBG_STOP >= 3) { RUNP(3); GSYNC(); }
    if (DBG_STOP >= 4) { RUNP(4); GSYNC(); }
    if (DBG_STOP >= 5) { RUNP(5); GSYNC(); }
    if (DBG_STOP >= 6) { RUNP(6); GSYNC(); }
    if (DBG_STOP >= 7) { RUNP(7); GSYNC(); }
#ifdef DBG_PRE_OFF
    { const bf16_t* s0 = (const bf16_t*)P.out + (size_t)DBG_PRE_OFF; bf16_t* d0 = (bf16_t*)(P.ws + WS_Y);
      for (size_t i = (size_t)blockIdx.x * NTHREADS + threadIdx.x; i < (size_t)M * DM; i += (size_t)gridDim.x * NTHREADS) d0[i] = s0[i];
      GSYNC(); }
#endif
    { const bf16_t* src = (const bf16_t*)(P.ws + (size_t)DBG_OFF); const float* srcf = (const float*)(P.ws + (size_t)DBG_OFF);
      for (size_t i = (size_t)blockIdx.x * NTHREADS + threadIdx.x; i < (size_t)M * DM; i += (size_t)gridDim.x * NTHREADS) {
#ifdef DBG_F32
        const float v = (i < (size_t)DBG_N) ? srcf[i] : 0.f;
#else
#ifdef DBG_LD
        const float v = bflo((unsigned)src[(i >> 10) * (size_t)DBG_LD + DBG_COL0 + (i & 1023)]);
#else
        const float v = bflo((unsigned)src[i]);
#endif
#endif
#ifdef DBG_NANDET
        P.out[i] = ((fabsf(v) < 1e30f) || (int)(i & 1023) < DBG_CMIN || (int)(i & 1023) >= DBG_CMAX) ? 0.f : 1e6f;
#else
        P.out[i] = v;
#endif
      } }
#endif
}
#if N_LAUNCH_SPLIT
__global__ void __launch_bounds__(NTHREADS, 2) fwd_phase(Params P, int ph) {
    extern __shared__ __attribute__((aligned(16))) unsigned char lds_raw[];
    LAS unsigned char* lds = (LAS unsigned char*)lds_raw;
    const int tid = threadIdx.x, lane = tid & 63, wave = __builtin_amdgcn_readfirstlane(tid >> 6);
    run_phase(P, lds, ph, tid, lane, wave);
}
#endif

extern "C" void kernel_launch(void* const* d_in, const int* in_sizes, int n_in, void* d_out, int out_size, void* d_ws, size_t ws_size, hipStream_t stream) {
    static int grid_blocks = 0;
    if (!grid_blocks) {
        int dev = 0, cus = 0, per_cu = 0;
        hipGetDevice(&dev);
        hipDeviceGetAttribute(&cus, hipDeviceAttributeMultiprocessorCount, dev);
        hipFuncSetAttribute((const void*)fwd_mega, hipFuncAttributeMaxDynamicSharedMemorySize, LDS_BYTES);
#if N_LAUNCH_SPLIT
        hipFuncSetAttribute((const void*)fwd_phase, hipFuncAttributeMaxDynamicSharedMemorySize, LDS_BYTES);
#endif
        if (hipOccupancyMaxActiveBlocksPerMultiprocessor(&per_cu, (const void*)fwd_mega, NTHREADS, LDS_BYTES) != hipSuccess || per_cu < 1) per_cu = 1;
        (void)hipGetLastError();
        if (cus <= 0) cus = 256;
        grid_blocks = cus * 1;
    }
    (void)hipMemsetAsync((unsigned char*)d_ws + WS_BAR, 0, 16 * KiB, stream);
    Params p{};
    for (int i = 0; i < 18; ++i) p.in[i] = (const float*)d_in[i];
    p.out = (float*)d_out; p.ws = (unsigned char*)d_ws;
#if N_LAUNCH_SPLIT
    for (int ph = 0; ph < NPHASE; ++ph) hipLaunchKernelGGL(fwd_phase, dim3(grid_blocks), dim3(NTHREADS), LDS_BYTES, stream, p, ph);
#else
    void* args[] = {&p};
    hipError_t e = hipLaunchCooperativeKernel((const void*)fwd_mega, dim3(grid_blocks), dim3(NTHREADS), args, LDS_BYTES, stream);
    if (e != hipSuccess) fprintf(stderr, "cooperative launch failed: %s (grid %d)\n", hipGetErrorString(e), grid_blocks);
#endif
}
```
